# Optimizing an MI355X kernel written in HIP

```python
import math
import jax, jax.numpy as jnp
from jax import lax
import numpy as np

D_MODEL = 2048
BATCH = 2
SEQ = 4096
DEPTH = 1

D_MIX = D_MODEL
D_ATTN = D_MIX // 2
D_CONV = D_MIX - D_ATTN
HEAD_DIM = 128
N_Q_HEADS = D_ATTN // HEAD_DIM
N_KV_HEADS = 2
GQA = N_Q_HEADS // N_KV_HEADS
D_KV = N_KV_HEADS * HEAD_DIM
L_CMP = 32
STRIDE_CMP = 16
L_SEL = 64
N_SEL = 16
WINDOW = 512
Q_BLOCK = 128
FORCED_SCORE = float(GQA + 1)
CONV_WIDTH = 3
CONV_GROUPS = 8
NUM_BUCKETS = 32
MAX_DISTANCE = 128
PEER_HEADS = 8
N_KEYS = 128
N_EXPERTS = N_KEYS * N_KEYS
PEER_TOPK = 16
D_KEY = 256
D_KEY_HALF = D_KEY // 2
TOK_BLOCK = 128
EPS = 1e-6
IN_SPLITS = (D_ATTN, D_KV, D_KV, D_KV, D_KV, D_KV, D_KV, 3 * N_Q_HEADS, D_CONV, D_CONV, D_CONV)
D_IN_PROJ = sum(IN_SPLITS)

kernel_name = 'hymba_nsa_shortconv_peer_layer'


def rmsnorm(x, w):
    xf = x.astype(jnp.float32)
    y = xf * lax.rsqrt(jnp.mean(xf * xf, axis=-1, keepdims=True) + EPS)
    return y.astype(x.dtype) * w


def group_rmsnorm(x, w, n_groups):
    shp = x.shape
    xg = x.reshape(shp[:-1] + (n_groups, shp[-1] // n_groups)).astype(jnp.float32)
    y = xg * lax.rsqrt(jnp.mean(xg * xg, axis=-1, keepdims=True) + EPS)
    return y.reshape(shp).astype(x.dtype) * w


def masked_softmax(s, mask):
    s = jnp.where(mask, s, -jnp.inf)
    m = jnp.max(s, axis=-1, keepdims=True)
    m = jnp.where(jnp.isfinite(m), m, 0.0)
    e = jnp.exp(s - m)
    d = jnp.sum(e, axis=-1, keepdims=True)
    return e / jnp.where(d > 0, d, 1.0)


def t5_bucket(dist):
    n = jnp.maximum(dist, 0)
    max_exact = NUM_BUCKETS // 2
    nf = jnp.maximum(n, 1).astype(jnp.float32)
    large = max_exact + (jnp.log(nf / max_exact) / math.log(MAX_DISTANCE / max_exact)
                         * (NUM_BUCKETS - max_exact)).astype(jnp.int32)
    large = jnp.minimum(large, NUM_BUCKETS - 1)
    return jnp.where(n < max_exact, n, large)


def selection_overlap(S):
    n_c = (S - L_CMP) // STRIDE_CMP + 1
    n_sel = S // L_SEL
    pos = np.arange(n_c)[:, None] * STRIDE_CMP + np.arange(L_CMP)[None, :]
    m = np.zeros((n_c, n_sel), np.float32)
    np.add.at(m, (np.repeat(np.arange(n_c), L_CMP), (pos // L_SEL).reshape(-1)), 1.0 / L_CMP)
    return jnp.asarray(m)


def nsa_mixer(q, k_cmp_in, v_cmp_in, k_sel, v_sel, k_win, v_win, gate_logits,
              w_cmp_k, w_cmp_v, cmp_pos, rel_bias):
    B, S = q.shape[:2]
    scale = HEAD_DIM ** -0.5
    q = q.reshape(B, S, N_KV_HEADS, GQA, HEAD_DIM)
    kvs = lambda a: a.reshape(B, S, N_KV_HEADS, HEAD_DIM)
    k_cmp_in, v_cmp_in, k_sel, v_sel, k_win, v_win = map(kvs, (k_cmp_in, v_cmp_in, k_sel, v_sel, k_win, v_win))
    t = np.arange(S)

    n_c = (S - L_CMP) // STRIDE_CMP + 1
    blk_pos = np.arange(n_c)[:, None] * STRIDE_CMP + np.arange(L_CMP)[None, :]

    def compress(k, w):
        blocks = k[:, blk_pos] + cmp_pos[None, None, :, None, :]
        return jnp.einsum('bnlhd,lde->bnhe', blocks, w)

    kc = compress(k_cmp_in, w_cmp_k)
    vc = compress(v_cmp_in, w_cmp_v)
    dist_c = t[:, None] - blk_pos[:, -1][None, :]
    bias_c = rel_bias[t5_bucket(dist_c)].reshape(S, n_c, N_KV_HEADS, GQA).transpose(2, 3, 0, 1)
    s_c = jnp.einsum('bqhgd,bnhd->bhgqn', q, kc).astype(jnp.float32) * scale + bias_c
    p_c = masked_softmax(s_c, dist_c >= 0)
    o_cmp = jnp.einsum('bhgqn,bnhd->bqhgd', p_c.astype(vc.dtype), vc)

    n_sel = S // L_SEL
    n_top = min(N_SEL, n_sel)
    imp = jnp.einsum('bhgqn,nj->bhqj', p_c, selection_overlap(S))
    j = np.arange(n_sel)[None, :]
    blk_t = (t // L_SEL)[:, None]
    forced = (j == 0) | (j == blk_t) | (j == blk_t - 1)
    causal_blk = j * L_SEL <= t[:, None]
    score = jnp.where(forced, FORCED_SCORE, jnp.where(causal_blk, imp, -1.0))
    _, sel_idx = lax.top_k(score, n_top)

    n_qb = S // Q_BLOCK
    q_ch = q.reshape(B, n_qb, Q_BLOCK, N_KV_HEADS, GQA, HEAD_DIM).transpose(1, 0, 2, 3, 4, 5)
    idx_ch = sel_idx.reshape(B, N_KV_HEADS, n_qb, Q_BLOCK, n_top).transpose(2, 0, 1, 3, 4)
    ks_blk = k_sel.reshape(B, n_sel, L_SEL, N_KV_HEADS, HEAD_DIM).transpose(0, 3, 1, 2, 4)
    vs_blk = v_sel.reshape(B, n_sel, L_SEL, N_KV_HEADS, HEAD_DIM).transpose(0, 3, 1, 2, 4)
    pad = ((0, 0), (WINDOW, 0), (0, 0), (0, 0))
    kw_pad = jnp.pad(k_win, pad)
    vw_pad = jnp.pad(v_win, pad)
    rel_bias_g = rel_bias.reshape(NUM_BUCKETS, N_KV_HEADS, GQA)
    gather = jax.vmap(jax.vmap(lambda blocks, ids: blocks[ids]))
    h_ar = jnp.arange(N_KV_HEADS)[None, :, None, None]
    win_off = jnp.arange(WINDOW + Q_BLOCK) - WINDOW
    n_k = n_top * L_SEL

    def block_fn(args):
        c, qc, ic = args
        t_q = c * Q_BLOCK + jnp.arange(Q_BLOCK)
        kg = gather(ks_blk, ic).reshape(B, N_KV_HEADS, Q_BLOCK, n_k, HEAD_DIM)
        vg = gather(vs_blk, ic).reshape(B, N_KV_HEADS, Q_BLOCK, n_k, HEAD_DIM)
        pos = (ic[..., None] * L_SEL + jnp.arange(L_SEL)).reshape(B, N_KV_HEADS, Q_BLOCK, n_k)
        dist = t_q[None, None, :, None] - pos
        bias = rel_bias_g[t5_bucket(dist), h_ar].transpose(0, 1, 4, 2, 3)
        s = jnp.einsum('bqhgd,bhqkd->bhgqk', qc, kg).astype(jnp.float32) * scale + bias
        p = masked_softmax(s, (dist >= 0)[:, :, None])
        o_s = jnp.einsum('bhgqk,bhqkd->bqhgd', p.astype(vg.dtype), vg)
        kw = lax.dynamic_slice_in_dim(kw_pad, c * Q_BLOCK, WINDOW + Q_BLOCK, axis=1)
        vw = lax.dynamic_slice_in_dim(vw_pad, c * Q_BLOCK, WINDOW + Q_BLOCK, axis=1)
        pos_w = c * Q_BLOCK + win_off
        dist_w = t_q[:, None] - pos_w[None, :]
        valid_w = (dist_w >= 0) & (dist_w < WINDOW) & (pos_w >= 0)[None, :]
        bias_w = rel_bias[t5_bucket(dist_w)].reshape(Q_BLOCK, WINDOW + Q_BLOCK, N_KV_HEADS, GQA).transpose(2, 3, 0, 1)
        s_w = jnp.einsum('bqhgd,bkhd->bhgqk', qc, kw).astype(jnp.float32) * scale + bias_w
        p_w = masked_softmax(s_w, valid_w)
        o_w = jnp.einsum('bhgqk,bkhd->bqhgd', p_w.astype(vw.dtype), vw)
        return o_s, o_w

    o_sel, o_win = lax.map(block_fn, (jnp.arange(n_qb), q_ch, idx_ch))
    unblock = lambda o: o.transpose(1, 0, 2, 3, 4, 5).reshape(B, S, N_KV_HEADS, GQA, HEAD_DIM)
    o_sel, o_win = unblock(o_sel), unblock(o_win)

    g = jax.nn.sigmoid(gate_logits.astype(jnp.float32)).reshape(B, S, N_KV_HEADS, GQA, 3).astype(q.dtype)
    o = g[..., 0:1] * o_cmp + g[..., 1:2] * o_sel + g[..., 2:3] * o_win
    return o.reshape(B, S, D_ATTN)


def short_conv_mixer(b_gate, c_gate, h, conv_w, conv_b):
    u = c_gate * h
    y = lax.conv_general_dilated(u, conv_w[:, None, :].astype(u.dtype), window_strides=(1,),
                                 padding=[(CONV_WIDTH - 1, 0)],
                                 dimension_numbers=('NWC', 'WIO', 'NWC'),
                                 feature_group_count=D_CONV) + conv_b
    return b_gate * y


def peer_ffn(x, wq, subkeys, u_tab, v_tab):
    B, S, D = x.shape
    T = B * S
    xt = x.reshape(T, D)
    q = (xt @ wq).reshape(T, PEER_HEADS, 2, D_KEY_HALF)
    s = jnp.einsum('thcd,hcnd->thcn', q, subkeys).astype(jnp.float32)
    sv, si = lax.top_k(s, PEER_TOPK)
    cand = (sv[:, :, 0, :, None] + sv[:, :, 1, None, :]).reshape(T, PEER_HEADS, PEER_TOPK * PEER_TOPK)
    cv, ci = lax.top_k(cand, PEER_TOPK)
    i1 = jnp.take_along_axis(si[:, :, 0], ci // PEER_TOPK, axis=-1)
    i2 = jnp.take_along_axis(si[:, :, 1], ci % PEER_TOPK, axis=-1)
    experts = i1 * N_KEYS + i2
    gates = jax.nn.softmax(cv, axis=-1)
    n_tb = T // TOK_BLOCK

    def block_fn(args):
        xc, ec, gc = args
        u = u_tab[ec]
        a = jax.nn.gelu(jnp.einsum('thkd,td->thk', u, xc).astype(jnp.float32))
        w = (gc * a).astype(xc.dtype)
        return jnp.einsum('thk,thkd->td', w, v_tab[ec])

    out = lax.map(block_fn, (xt.reshape(n_tb, TOK_BLOCK, D),
                             experts.reshape(n_tb, TOK_BLOCK, PEER_HEADS, PEER_TOPK),
                             gates.reshape(n_tb, TOK_BLOCK, PEER_HEADS, PEER_TOPK)))
    return out.reshape(B, S, D)


def setup_inputs(seed: int = 0) -> dict:
    key = jax.random.key(seed)
    ks = jax.random.split(key, 20)
    nrm = lambda k, shp, sc: jax.random.normal(k, shp, jnp.float32) * sc
    return {
        'x': nrm(ks[0], (BATCH, SEQ, D_MODEL), 1.0),
        'attn_norm_w': 1.0 + nrm(ks[1], (DEPTH, D_MODEL), 0.02),
        'w_in': nrm(ks[2], (DEPTH, D_MODEL, D_IN_PROJ), D_MODEL ** -0.5),
        'w_cmp_k': nrm(ks[3], (DEPTH, L_CMP, HEAD_DIM, HEAD_DIM), (L_CMP * HEAD_DIM) ** -0.5),
        'w_cmp_v': nrm(ks[4], (DEPTH, L_CMP, HEAD_DIM, HEAD_DIM), (L_CMP * HEAD_DIM) ** -0.5),
        'cmp_pos': nrm(ks[5], (DEPTH, L_CMP, HEAD_DIM), 0.1),
        'conv_w': nrm(ks[6], (DEPTH, CONV_WIDTH, D_CONV), CONV_WIDTH ** -0.5),
        'conv_b': nrm(ks[7], (DEPTH, D_CONV), 0.02),
        'attn_group_norm_w': 1.0 + nrm(ks[8], (DEPTH, D_ATTN), 0.02),
        'conv_group_norm_w': 1.0 + nrm(ks[9], (DEPTH, D_CONV), 0.02),
        'w_out': nrm(ks[10], (DEPTH, D_MIX, D_MODEL), D_MIX ** -0.5),
        'rel_bias': nrm(ks[11], (NUM_BUCKETS, N_Q_HEADS), 0.2),
        'ffn_norm_w': 1.0 + nrm(ks[12], (DEPTH, D_MODEL), 0.02),
        'peer_wq': nrm(ks[13], (DEPTH, D_MODEL, PEER_HEADS * D_KEY), D_MODEL ** -0.5),
        'peer_subkeys': nrm(ks[14], (DEPTH, PEER_HEADS, 2, N_KEYS, D_KEY_HALF), D_KEY_HALF ** -0.5),
        'peer_u': nrm(ks[15], (DEPTH, N_EXPERTS, D_MODEL), D_MODEL ** -0.5),
        'peer_v': nrm(ks[16], (DEPTH, N_EXPERTS, D_MODEL), (PEER_HEADS * PEER_TOPK) ** -0.5),
        'final_norm_w': 1.0 + nrm(ks[17], (D_MODEL,), 0.02),
    }


def reference(x, attn_norm_w, w_in, w_cmp_k, w_cmp_v, cmp_pos, conv_w, conv_b,
              attn_group_norm_w, conv_group_norm_w, w_out, rel_bias, ffn_norm_w,
              peer_wq, peer_subkeys, peer_u, peer_v, final_norm_w):
    split_at = list(np.cumsum(IN_SPLITS)[:-1])
    h = x
    for l in range(DEPTH):
        xn = rmsnorm(h, attn_norm_w[l])
        proj = xn @ w_in[l]
        (q, k_c, v_c, k_s, v_s, k_w, v_w, gate_logits,
         b_gate, c_gate, h_conv) = jnp.split(proj, split_at, axis=-1)
        o_attn = nsa_mixer(q, k_c, v_c, k_s, v_s, k_w, v_w, gate_logits,
                           w_cmp_k[l], w_cmp_v[l], cmp_pos[l], rel_bias)
        o_conv = short_conv_mixer(b_gate, c_gate, h_conv, conv_w[l], conv_b[l])
        mixed = jnp.concatenate([group_rmsnorm(o_attn, attn_group_norm_w[l], N_Q_HEADS),
                                 group_rmsnorm(o_conv, conv_group_norm_w[l], CONV_GROUPS)], axis=-1)
        h = h + mixed @ w_out[l]
        h = h + peer_ffn(rmsnorm(h, ffn_norm_w[l]), peer_wq[l], peer_subkeys[l], peer_u[l], peer_v[l])
    return rmsnorm(h, final_norm_w)
```

```cpp
#include <hip/hip_runtime.h>
#include <hip/hip_cooperative_groups.h>
#include <cstdio>
namespace cg = cooperative_groups;

#define LAS __attribute__((address_space(3)))
typedef unsigned short bf16;
typedef short bf16x8 __attribute__((ext_vector_type(8)));
typedef float f32x4 __attribute__((ext_vector_type(4)));
typedef float f32x2 __attribute__((ext_vector_type(2)));
typedef unsigned u32x4 __attribute__((ext_vector_type(4)));
typedef unsigned u32x2 __attribute__((ext_vector_type(2)));

constexpr int D_MODEL = 2048, BATCH = 2, SEQ = 4096, T_TOK = BATCH * SEQ;
constexpr int D_ATTN = 1024, D_CONV = 1024, HEAD_DIM = 128, N_KV = 2, GQA = 4;
constexpr int N_IN_PAD = 5888, N_IN = 5656;
constexpr int N_CMP = 255;
constexpr int N_EXPERTS = 16384;
constexpr float EPS = 1e-6f;
constexpr int NTHREADS = 512, NWAVES = 8;
constexpr int LDS_BYTES = 147456;
constexpr int LDS_CTL_OFF = LDS_BYTES - 64;
constexpr int U_ROWS_P0 = 4096, U_ROWS_FILL = 2048, U_NFILL = 6;
static_assert(U_ROWS_P0 + U_NFILL * U_ROWS_FILL == N_EXPERTS, "U conversion split");
constexpr int U_HALF_P0 = 32768;
constexpr int V_HALF_P0 = 0;

constexpr size_t MiB = 1u << 20;
constexpr size_t WS_WIN_T = 0;
constexpr size_t WS_WOUT_T = 24 * MiB;
constexpr size_t WS_WQ_T = 32 * MiB;
constexpr size_t WS_XN = 40 * MiB;
constexpr size_t WS_Q = 72 * MiB;
constexpr size_t WS_KC = 88 * MiB;
constexpr size_t WS_VC = 92 * MiB;
constexpr size_t WS_KS = 96 * MiB;
constexpr size_t WS_VST = 100 * MiB;
constexpr size_t WS_KW = 104 * MiB;
constexpr size_t WS_VWT = 108 * MiB;
constexpr size_t WS_BG = 112 * MiB;
constexpr size_t WS_CG = 128 * MiB;
constexpr size_t WS_HC = 144 * MiB;
constexpr size_t WS_GL = 160 * MiB;
constexpr size_t WS_MIXED = 162 * MiB;
constexpr size_t WS_APART = 72 * MiB;
constexpr size_t WS_H = 200 * MiB;
constexpr size_t WS_USC = 200 * MiB;
constexpr size_t WS_PQ = 264 * MiB;
constexpr size_t WS_U = 296 * MiB;
constexpr size_t WS_V = 360 * MiB;
constexpr size_t WS_WCK_T = 424 * MiB;
constexpr size_t WS_WCV_T = 425 * MiB;
constexpr size_t WS_SK = 426 * MiB;
constexpr size_t WS_KCMP = 427 * MiB;
constexpr size_t WS_VCMPT = 428 * MiB;
constexpr size_t WS_CCONST = 429 * MiB;
constexpr size_t WS_EIDX = 430 * MiB;
constexpr size_t WS_EW = 434 * MiB;
constexpr size_t WS_EW2 = 438 * MiB;
constexpr size_t WS_CTL = 442 * MiB;
constexpr size_t CTL_BYTES = 65536;
constexpr size_t WS_SSP = 443 * MiB;
constexpr size_t WS_R = 444 * MiB;
constexpr size_t WS_PD = 445 * MiB;
constexpr size_t WS_END = 477 * MiB;
static_assert(WS_APART + (size_t)16 * 8192 * 128 * 4 <= WS_H, "APART overlay");

struct Params {
    const float* in[18];
    float* out;
    unsigned char* ws;
    int ph_lo, ph_hi;
};
enum { I_X = 0, I_ANW, I_WIN, I_WCK, I_WCV, I_CPOS, I_CW, I_CB, I_AGNW, I_CGNW, I_WOUT, I_RB, I_FNW, I_PWQ, I_PSK, I_PU, I_PV, I_FINW };

__device__ __forceinline__ unsigned f2bf(float f) { unsigned u = __builtin_bit_cast(unsigned, f); return (u + 0x7fffu + ((u >> 16) & 1u)) >> 16; }
__device__ __forceinline__ unsigned pk2(float lo, float hi) { unsigned r; asm("v_cvt_pk_bf16_f32 %0, %1, %2" : "=v"(r) : "v"(lo), "v"(hi)); return r; }
__device__ __forceinline__ float bf_lo(unsigned w) { return __builtin_bit_cast(float, w << 16); }
__device__ __forceinline__ float bf_hi(unsigned w) { return __builtin_bit_cast(float, w & 0xffff0000u); }
__device__ __forceinline__ float wave_sum(float v) {
#pragma unroll
    for (int o = 1; o < 64; o <<= 1) v += __shfl_xor(v, o);
    return v;
}
#define LDS_WAIT() asm volatile("s_waitcnt lgkmcnt(0)" ::: "memory")

#define XB_TMO      128
#define XB_XCNT(j)  (256  + 64 * (j))
#define XB_XSUB(j)  (1280 + 64 * (j))
#define XB_XGEN(j)  (2304 + 64 * (j))
#define XB_TOP      3328
#define XB_TOPGEN   3392
#define XCD_BAR_WORDS 3456
#define XB_SPIN_CAP (1u << 20)
__device__ __forceinline__ unsigned xb_ld(unsigned* p)              { return __hip_atomic_load(p, __ATOMIC_RELAXED, __HIP_MEMORY_SCOPE_AGENT); }
__device__ __forceinline__ unsigned xb_add(unsigned* p, unsigned v) { return __hip_atomic_fetch_add(p, v, __ATOMIC_RELAXED, __HIP_MEMORY_SCOPE_AGENT); }
__device__ __forceinline__ unsigned xb_xcc_id() { return (unsigned)__builtin_amdgcn_s_getreg((3 << 11) | 20) & 0xFu; }
#define XB_SPIN(cond, bar) do { unsigned _sp = 0; while (cond) { __builtin_amdgcn_s_sleep(1); \
    if ((++_sp & 255u) == 0u) { if (xb_ld(&(bar)[XB_TMO])) break; if (_sp > XB_SPIN_CAP) { atomicAdd(&(bar)[XB_TMO], 1u); break; } } } } while (0)
struct XcdBarrier { unsigned* bar; unsigned x; unsigned rank; volatile LAS unsigned* st; };
__device__ __forceinline__ XcdBarrier xcd_barrier_post(unsigned* bar, volatile LAS unsigned* st) {
    XcdBarrier b; b.bar = bar; b.x = xb_xcc_id(); b.st = st; b.rank = 0;
    if (threadIdx.x == 0) st[2] = xb_add(&bar[XB_XCNT(b.x)], 1u);
    return b;
}
__device__ __forceinline__ void xcd_barrier_complete(unsigned* bar, unsigned x, unsigned& nloc, unsigned& nx) {
    const unsigned G = gridDim.x * gridDim.y * gridDim.z;
    unsigned sum, cnt, mine, sp = 0u;
    for (;;) {
        sum = 0u; cnt = 0u; mine = 0u;
#pragma unroll
        for (unsigned j = 0; j < 16; ++j) { const unsigned c = xb_ld(&bar[XB_XCNT(j)]); sum += c; cnt += (c > 0u) ? 1u : 0u; mine = (j == x) ? c : mine; }
        if (sum == G) break;
        __builtin_amdgcn_s_sleep(1);
        if ((++sp & 255u) == 0u) { if (xb_ld(&bar[XB_TMO])) break; if (sp > XB_SPIN_CAP) { atomicAdd(&bar[XB_TMO], 1u); break; } }
    }
    nloc = mine > 0u ? mine : 1u; nx = cnt > 0u ? cnt : 1u;
}
__device__ __forceinline__ unsigned xcd_barrier_arrive(const XcdBarrier& b) {
    unsigned target = 0u;
    asm volatile("s_waitcnt vmcnt(0)" ::: "memory");
    __syncthreads();
    if (threadIdx.x == 0) {
        unsigned* bar = b.bar;
        __builtin_amdgcn_s_waitcnt(0);
        unsigned nloc = b.st[0], nx = b.st[1];
        if (nloc == 0u) { xcd_barrier_complete(bar, b.x, nloc, nx); b.st[0] = nloc; b.st[1] = nx; }
        const unsigned old = xb_add(&bar[XB_XSUB(b.x)], 1u);
        const unsigned gen = old / nloc; target = (gen + 1u) * nx;
        if (old + 1u == (gen + 1u) * nloc) {
            __builtin_amdgcn_fence(__ATOMIC_RELEASE, "agent");
            asm volatile("s_waitcnt vmcnt(0)" ::: "memory");
            (void)xb_add(&bar[XB_TOP], 1u);
        }
    }
    return target;
}
__device__ __forceinline__ void xcd_barrier_wait(const XcdBarrier& b, unsigned target) {
    if (threadIdx.x == 0) {
        unsigned* bar = b.bar;
        XB_SPIN(xb_ld(&bar[XB_TOP]) < target, bar);
        __builtin_amdgcn_fence(__ATOMIC_ACQUIRE, "agent");
        asm volatile("s_waitcnt vmcnt(0)" ::: "memory");
    }
    __syncthreads();
}
__device__ __forceinline__ void xcd_barrier(const XcdBarrier& b) {
    asm volatile("s_waitcnt vmcnt(0)" ::: "memory");
    __syncthreads();
    if (threadIdx.x == 0) {
        unsigned* bar = b.bar;
        __builtin_amdgcn_s_waitcnt(0);
        unsigned nloc = b.st[0], nx = b.st[1];
        if (nloc == 0u) { xcd_barrier_complete(bar, b.x, nloc, nx); b.st[0] = nloc; b.st[1] = nx; }
        const unsigned old = xb_add(&bar[XB_XSUB(b.x)], 1u);
        const unsigned gen = old / nloc, target = (gen + 1u) * nx;
        if (old + 1u == (gen + 1u) * nloc) {
            __builtin_amdgcn_fence(__ATOMIC_RELEASE, "agent");
            asm volatile("s_waitcnt vmcnt(0)" ::: "memory");
            (void)xb_add(&bar[XB_TOP], 1u);
        }
        XB_SPIN(xb_ld(&bar[XB_TOP]) < target, bar);
        __builtin_amdgcn_fence(__ATOMIC_ACQUIRE, "agent");
        asm volatile("s_waitcnt vmcnt(0)" ::: "memory");
    }
    __syncthreads();
}

namespace pg8 {
#define PG8_LAS __attribute__((address_space(3)))
typedef unsigned short bf16_t;
typedef short bf16x8 __attribute__((ext_vector_type(8)));
typedef float f32x4 __attribute__((ext_vector_type(4)));
typedef unsigned u32x4 __attribute__((ext_vector_type(4)));
constexpr int BM = 256, BK = 64, HALF = 128, HTB = HALF * BK * 2  , STAGE_BYTES = 8 * HTB, NXCD = 8, WGM = 8;

__host__ __device__ __forceinline__ int lds_byte(int r, int c) { const int st = (r >> 4) * 2 + (c >> 5), rr = r & 15, cc = c & 31, ob = rr * 64 + cc * 2; return st * 1024 + (ob ^ (((ob >> 9) & 1) << 5)); }
__host__ __device__ __forceinline__ void stage_rc(int b, int& R, int& C) { const int st = b / 1024, sb = b % 1024, swz = sb ^ (((sb >> 9) & 1) << 5); R = (st >> 1) * 16 + swz / 64; C = (st & 1) * 32 + (swz % 64) / 2; }
__host__ __device__ __forceinline__ int perm32(int rho) { const int n = rho >> 4, i = rho & 15; return 8 * (i >> 2) + 4 * n + (i & 3); }

struct Unit { int pm, pn; };
struct Gemm { const bf16_t* A; const bf16_t* Bt; int M, N, K; };

struct StaticOrder {
    int nM, nN, nwg, G, c, rep;
    __host__ __device__ void init(int M, int N, int G_, int c_, int rep_ = 1) { nM = M / BM; nN = N / BM; nwg = nM * nN; G = G_; c = c_; rep = rep_; }
    __host__ __device__ bool next(int i, Unit& u) const {
        const long L = (long)i * G + c; if (L >= (long)nwg * rep) return false;
        int wgid = (int)(L % nwg); { const int q = nwg / NXCD, r = nwg % NXCD, xcd = wgid % NXCD, off = wgid / NXCD; wgid = (xcd < r ? xcd * (q + 1) : r * (q + 1) + (xcd - r) * q) + off; }
        const int nig = WGM * nN, gid = wgid / nig, fm = gid * WGM, gsz = (nM - fm) < WGM ? (nM - fm) : WGM;
        u.pm = fm + ((wgid % nig) % gsz); u.pn = (wgid % nig) / gsz; return true;
    }
    __device__ __forceinline__ void a_ready(const Unit&) const {}
    __device__ __forceinline__ void done(const Unit&) const {}
};

template <class Epi, class Sched>
__device__ __forceinline__ void gemm_phase(PG8_LAS unsigned char* lds, const Gemm g, const Sched& S, const Epi& E) {
    const int tid = threadIdx.x, wid = __builtin_amdgcn_readfirstlane(tid >> 6), lane = tid & 63, wr = wid >> 2, wc = wid & 3, fr = lane & 15, fq = lane >> 4;
    const int K = g.K, nt = K / BK;
    unsigned voffA[2], voffB[2];
#pragma unroll
    for (int i = 0; i < 2; ++i) { int R, C; stage_rc(tid * 16 + i * 8192, R, C); const int Rb = Epi::PERM ? ((R & ~31) + perm32(R & 31)) : R;
        voffA[i] = (unsigned)(R * K + C) * 2u; voffB[i] = (unsigned)(Rb * K + C) * 2u; }
    const size_t kstep = (size_t)(BK * 2);
    const size_t hstep = (size_t)HALF * K * 2;
    const size_t tstep = 2 * hstep;
    const unsigned ldsw = (unsigned)wid * 1024u;
    const int aoff = lds_byte(wr * 64 + fr, fq * 8), boff = lds_byte(wc * 32 + fr, fq * 8);
#define PG8_SA(b, h) (((b) * 2 + (h)) * HTB)
#define PG8_SB(b, h) ((4 + (b) * 2 + (h)) * HTB)
#define PG8_STAGE(bufoff, gbase, voff) do { _Pragma("unroll") for (int _i = 0; _i < 2; ++_i) \
        __builtin_amdgcn_global_load_lds((const unsigned*)((const char*)(gbase) + (voff)[_i]), (PG8_LAS unsigned*)(lds + (bufoff) + ldsw + _i * 8192), 16, 0, 0); } while (0)
#define PG8_LDA(dst, b, h) do { _Pragma("unroll") for (int m = 0; m < 4; ++m) _Pragma("unroll") for (int k = 0; k < 2; ++k) dst[m][k] = *(const PG8_LAS bf16x8*)(lds + PG8_SA(b, h) + aoff + m * 2048 + k * 1024); } while (0)
#define PG8_LDB(dst, b, h) do { _Pragma("unroll") for (int n = 0; n < 2; ++n) _Pragma("unroll") for (int k = 0; k < 2; ++k) dst[n][k] = *(const PG8_LAS bf16x8*)(lds + PG8_SB(b, h) + boff + n * 2048 + k * 1024); } while (0)
#define PG8_MMA(ai, bj, At, Bt) do { __builtin_amdgcn_s_setprio(1); _Pragma("unroll") for (int m = 0; m < 4; ++m) _Pragma("unroll") for (int n = 0; n < 2; ++n) _Pragma("unroll") for (int k = 0; k < 2; ++k) \
        acc[ai][bj][m][n] = __builtin_amdgcn_mfma_f32_16x16x32_bf16(Bt[n][k], At[m][k], acc[ai][bj][m][n], 0, 0, 0); __builtin_amdgcn_s_setprio(0); } while (0)
#define PG8_WAIT_V(n) asm volatile("s_waitcnt vmcnt(" #n ")" ::: "memory")
#define PG8_WAIT_L(n) asm volatile("s_waitcnt lgkmcnt(" #n ")" ::: "memory")
#define PG8_BAR __builtin_amdgcn_s_barrier()
#define PG8_SCHED __builtin_amdgcn_sched_barrier(0)
    Unit cur, nxt; int ui = 0;
    if (!S.next(0, cur)) return;
    f32x4 acc[2][2][4][2];
#pragma unroll
    for (int a = 0; a < 2; ++a)
#pragma unroll
        for (int b = 0; b < 2; ++b)
#pragma unroll
            for (int m = 0; m < 4; ++m)
#pragma unroll
                for (int n = 0; n < 2; ++n) acc[a][b][m][n] = (f32x4){0.f, 0.f, 0.f, 0.f};
    bf16x8 At[4][2], B0[2][2], B1[2][2];
    const char* cA = (const char*)g.A + (size_t)cur.pm * tstep; const char* cB = (const char*)g.Bt + (size_t)cur.pn * tstep;
    S.a_ready(cur);
    PG8_STAGE(PG8_SB(0, 0), cB, voffB); PG8_STAGE(PG8_SA(0, 0), cA, voffA); PG8_STAGE(PG8_SB(0, 1), cB + hstep, voffB); PG8_STAGE(PG8_SA(0, 1), cA + hstep, voffA);
    if (wr == 1) PG8_BAR;
    PG8_WAIT_V(4); PG8_BAR;
    PG8_STAGE(PG8_SB(1, 0), cB + kstep, voffB); PG8_STAGE(PG8_SA(1, 0), cA + kstep, voffA); PG8_STAGE(PG8_SB(1, 1), cB + hstep + kstep, voffB);
    PG8_WAIT_V(6); PG8_BAR;
    for (;;) {
        const bool has_next = S.next(ui + 1, nxt);
        const char* nA = has_next ? (const char*)g.A + (size_t)nxt.pm * tstep : cA; const char* nB = has_next ? (const char*)g.Bt + (size_t)nxt.pn * tstep : cB;
        for (int t = 0; t < nt; t += 2) {
            const bool last = (t == nt - 2);
            const char* a1 = cA + (size_t)(t + 1) * kstep;
            const char* a2 = last ? nA : cA + (size_t)(t + 2) * kstep; const char* b2 = last ? nB : cB + (size_t)(t + 2) * kstep;
            const char* a3 = a2 + kstep; const char* b3 = b2 + kstep;
            if (last && has_next) S.a_ready(nxt);
            PG8_LDB(B0, 0, 0); PG8_SCHED; PG8_LDA(At, 0, 0); PG8_STAGE(PG8_SA(1, 1), a1 + hstep, voffA);
            PG8_WAIT_L(8); PG8_BAR; PG8_WAIT_L(0); PG8_MMA(0, 0, At, B0); PG8_BAR; PG8_SCHED;
            PG8_LDB(B1, 0, 1); PG8_STAGE(PG8_SB(0, 0), b2, voffB);
            PG8_BAR; PG8_WAIT_L(0); PG8_MMA(0, 1, At, B1); PG8_BAR;
            PG8_LDA(At, 0, 1); PG8_STAGE(PG8_SA(0, 0), a2, voffA);
            PG8_BAR; PG8_WAIT_L(0); PG8_MMA(1, 0, At, B0); PG8_BAR; PG8_SCHED;
            PG8_STAGE(PG8_SB(0, 1), b2 + hstep, voffB);
            PG8_WAIT_V(6); PG8_BAR; PG8_MMA(1, 1, At, B1); PG8_BAR;
            PG8_LDB(B0, 1, 0); PG8_SCHED; PG8_LDA(At, 1, 0); PG8_STAGE(PG8_SA(0, 1), a2 + hstep, voffA);
            PG8_WAIT_L(8); PG8_BAR; PG8_WAIT_L(0); PG8_MMA(0, 0, At, B0); PG8_BAR; PG8_SCHED;
            PG8_LDB(B1, 1, 1); PG8_STAGE(PG8_SB(1, 0), b3, voffB);
            PG8_BAR; PG8_WAIT_L(0); PG8_MMA(0, 1, At, B1); PG8_BAR;
            PG8_LDA(At, 1, 1); PG8_STAGE(PG8_SA(1, 0), a3, voffA);
            PG8_BAR; PG8_WAIT_L(0); PG8_MMA(1, 0, At, B0); PG8_BAR; PG8_SCHED;
            PG8_STAGE(PG8_SB(1, 1), b3 + hstep, voffB);
            PG8_WAIT_V(6); PG8_BAR; PG8_MMA(1, 1, At, B1); PG8_BAR;
        }
        if constexpr (!Epi::AFTER_DRAIN) { E(acc, cur, wr, wc, fr, fq); S.done(cur); }
        if (!has_next) break;
#pragma unroll
        for (int a = 0; a < 2; ++a)
#pragma unroll
            for (int b = 0; b < 2; ++b)
#pragma unroll
                for (int m = 0; m < 4; ++m)
#pragma unroll
                    for (int n = 0; n < 2; ++n) acc[a][b][m][n] = (f32x4){0.f, 0.f, 0.f, 0.f};
        cur = nxt; cA = nA; cB = nB; ++ui;
    }
    PG8_WAIT_V(0);
    if (wr == 0) PG8_BAR;
    PG8_BAR;
    if constexpr (Epi::AFTER_DRAIN) { E.fused(acc, cur, wr, wc, fr, fq, lds, wid, lane); S.done(cur); }
#undef PG8_SA
#undef PG8_SB
#undef PG8_STAGE
#undef PG8_LDA
#undef PG8_LDB
#undef PG8_MMA
#undef PG8_WAIT_V
#undef PG8_WAIT_L
#undef PG8_BAR
#undef PG8_SCHED
}
}
struct EpiInProj {
    static constexpr bool PERM = true, AFTER_DRAIN = false;
    unsigned char* ws; float qscale;
    __device__ __forceinline__ void operator()(const pg8::f32x4 (&acc)[2][2][4][2], const pg8::Unit& u, int wr, int wc, int fr, int fq) const {
        const int pn = u.pn;
        const int row0 = u.pm * 256 + wr * 64 + fr;
        if (pn == 22) {
            if (wc == 0) {
                float* GL = (float*)(ws + WS_GL);
#pragma unroll
                for (int ai = 0; ai < 2; ++ai)
#pragma unroll
                    for (int m = 0; m < 4; ++m) { float* p = GL + (size_t)(row0 + ai * 128 + m * 16) * 32 + 8 * fq;
                        *(f32x4*)p = acc[ai][0][m][0]; *(f32x4*)(p + 4) = acc[ai][0][m][1]; }
            }
            return;
        }
        if (pn == 7 || pn == 9) {
            bf16* VT = (bf16*)(ws + (pn == 7 ? WS_VST : WS_VWT));
#pragma unroll
            for (int ai = 0; ai < 2; ++ai)
#pragma unroll
                for (int m = 0; m < 4; ++m) { const int row = row0 + ai * 128 + m * 16, b = row >> 12, s = row & 4095;
#pragma unroll
                    for (int bj = 0; bj < 2; ++bj) { bf16* p = VT + ((size_t)((b * 2 + bj) * 128 + wc * 32 + 8 * fq)) * SEQ + s;
#pragma unroll
                        for (int n = 0; n < 2; ++n)
#pragma unroll
                            for (int j = 0; j < 4; ++j) p[(size_t)(4 * n + j) * SEQ] = (bf16)f2bf(acc[ai][bj][m][n][j]); } }
            return;
        }
        if (pn >= 4 && pn <= 9) {
            bf16* KB = (bf16*)(ws + WS_KC + (size_t)(pn - 4) * 4 * MiB);
#pragma unroll
            for (int ai = 0; ai < 2; ++ai)
#pragma unroll
                for (int m = 0; m < 4; ++m) { const int row = row0 + ai * 128 + m * 16, b = row >> 12, s = row & 4095;
#pragma unroll
                    for (int bj = 0; bj < 2; ++bj) { bf16* p = KB + ((size_t)((b * 2 + bj) * SEQ + s)) * 128 + wc * 32 + 8 * fq;
                        const f32x4 v0 = acc[ai][bj][m][0], v1 = acc[ai][bj][m][1];
                        u32x4 w; w.x = pk2(v0[0], v0[1]); w.y = pk2(v0[2], v0[3]); w.z = pk2(v1[0], v1[1]); w.w = pk2(v1[2], v1[3]);
                        *(u32x4*)p = w; } }
            return;
        }
        bf16* O; int colt; float sc = 1.f;
        if (pn < 4) { O = (bf16*)(ws + WS_Q); colt = pn * 256; sc = qscale; }
        else { const int k = (pn - 10) >> 2; O = (bf16*)(ws + WS_BG + (size_t)k * 16 * MiB); colt = ((pn - 10) & 3) * 256; }
#pragma unroll
        for (int ai = 0; ai < 2; ++ai)
#pragma unroll
            for (int m = 0; m < 4; ++m) { bf16* rowp = O + (size_t)(row0 + ai * 128 + m * 16) * 1024 + colt + wc * 32 + 8 * fq;
#pragma unroll
                for (int bj = 0; bj < 2; ++bj) { const f32x4 v0 = acc[ai][bj][m][0] * sc, v1 = acc[ai][bj][m][1] * sc;
                    u32x4 w; w.x = pk2(v0[0], v0[1]); w.y = pk2(v0[2], v0[3]); w.z = pk2(v1[0], v1[1]); w.w = pk2(v1[2], v1[3]);
                    *(u32x4*)(rowp + bj * 128) = w; } }
    }
};
struct EpiResF32 {
    static constexpr bool PERM = false, AFTER_DRAIN = false;
    const float* res; float* C;
    __device__ __forceinline__ void operator()(const pg8::f32x4 (&acc)[2][2][4][2], const pg8::Unit& u, int wr, int wc, int fr, int fq) const {
        const int row0 = u.pm * 256 + wr * 64 + fr, col0 = u.pn * 256 + wc * 32 + 4 * fq;
#pragma unroll
        for (int ai = 0; ai < 2; ++ai)
#pragma unroll
            for (int m = 0; m < 4; ++m) { const size_t ro = (size_t)(row0 + ai * 128 + m * 16) * D_MODEL + col0;
#pragma unroll
                for (int bj = 0; bj < 2; ++bj)
#pragma unroll
                    for (int n = 0; n < 2; ++n) { const f32x4 r = *(const f32x4*)(res + ro + bj * 128 + n * 16); *(f32x4*)(C + ro + bj * 128 + n * 16) = acc[ai][bj][m][n] + r; } }
    }
};
__device__ __forceinline__ float epi_quad_sum(float v) {
    const auto a = __builtin_amdgcn_permlane32_swap(__builtin_bit_cast(unsigned, v), __builtin_bit_cast(unsigned, v), false, false); const unsigned a0 = a[0], a1 = a[1];
    const float m = __builtin_bit_cast(float, a0) + __builtin_bit_cast(float, a1);
    const auto b = __builtin_amdgcn_permlane16_swap(__builtin_bit_cast(unsigned, m), __builtin_bit_cast(unsigned, m), false, false); const unsigned b0 = b[0], b1 = b[1];
    return __builtin_bit_cast(float, b0) + __builtin_bit_cast(float, b1);
}
struct EpiResF32H {
    static constexpr bool PERM = true, AFTER_DRAIN = false;
    const float* res; float* C; bf16* HB; float* SSP;
    __device__ __forceinline__ void operator()(const pg8::f32x4 (&acc)[2][2][4][2], const pg8::Unit& u, int wr, int wc, int fr, int fq) const {
        const int row0 = u.pm * 256 + wr * 64 + fr, col0 = u.pn * 256 + wc * 32 + 8 * fq;
#pragma unroll
        for (int ai = 0; ai < 2; ++ai) {
            f32x4 rr[4][2][2];
#pragma unroll
            for (int m = 0; m < 4; ++m) { const size_t ro = (size_t)(row0 + ai * 128 + m * 16) * D_MODEL + col0;
#pragma unroll
                for (int bj = 0; bj < 2; ++bj) { rr[m][bj][0] = __builtin_nontemporal_load((const f32x4*)(res + ro + bj * 128)); rr[m][bj][1] = __builtin_nontemporal_load((const f32x4*)(res + ro + bj * 128 + 4)); } }
#pragma unroll
            for (int m = 0; m < 4; ++m) { const int row = row0 + ai * 128 + m * 16; const size_t ro = (size_t)row * D_MODEL + col0; float ss = 0.f;
#pragma unroll
                for (int bj = 0; bj < 2; ++bj) {
                    const f32x4 h0 = acc[ai][bj][m][0] + rr[m][bj][0], h1 = acc[ai][bj][m][1] + rr[m][bj][1];
                    u32x4 hb; hb.x = pk2(h0[0], h0[1]); hb.y = pk2(h0[2], h0[3]); hb.z = pk2(h1[0], h1[1]); hb.w = pk2(h1[2], h1[3]); *(u32x4*)(HB + ro + bj * 128) = hb;
                    ss += ((h0[0] * h0[0] + h0[1] * h0[1]) + (h0[2] * h0[2] + h0[3] * h0[3])) + ((h1[0] * h1[0] + h1[1] * h1[1]) + (h1[2] * h1[2] + h1[3] * h1[3])); }
                ss = epi_quad_sum(ss);
                if (fq == 0) SSP[(size_t)row * 32 + u.pn * 4 + wc] = ss; }
        }
    }
};
struct EpiBf16Row {
    static constexpr bool PERM = true, AFTER_DRAIN = false;
    bf16* O; int ldc; const float* SSP; float* R;
    __device__ __forceinline__ void operator()(const pg8::f32x4 (&acc)[2][2][4][2], const pg8::Unit& u, int wr, int wc, int fr, int fq) const {
        const int row0 = u.pm * 256 + wr * 64 + fr, col0 = u.pn * 256 + wc * 32 + 8 * fq;
        f32x4 pp[2][4][2];
#pragma unroll
        for (int ai = 0; ai < 2; ++ai)
#pragma unroll
            for (int m = 0; m < 4; ++m) { const int row = row0 + ai * 128 + m * 16;
                pp[ai][m][0] = *(const f32x4*)(SSP + (size_t)row * 32 + 8 * fq); pp[ai][m][1] = *(const f32x4*)(SSP + (size_t)row * 32 + 8 * fq + 4); }
#pragma unroll
        for (int ai = 0; ai < 2; ++ai)
#pragma unroll
            for (int m = 0; m < 4; ++m) { const int row = row0 + ai * 128 + m * 16;
                const f32x4 p0 = pp[ai][m][0], p1 = pp[ai][m][1];
                float ss = ((p0[0] + p0[1]) + (p0[2] + p0[3])) + ((p1[0] + p1[1]) + (p1[2] + p1[3]));
                ss = epi_quad_sum(ss);
                const float rr = 1.0f / sqrtf(ss * (1.f / D_MODEL) + EPS);
                if (u.pn == 0 && wc == 0 && fq == 0) R[row] = rr;
                bf16* rowp = O + (size_t)row * ldc + col0;
#pragma unroll
                for (int bj = 0; bj < 2; ++bj) { const f32x4 v0 = acc[ai][bj][m][0] * rr, v1 = acc[ai][bj][m][1] * rr;
                    u32x4 w; w.x = pk2(v0[0], v0[1]); w.y = pk2(v0[2], v0[3]); w.z = pk2(v1[0], v1[1]); w.w = pk2(v1[2], v1[3]);
                    *(u32x4*)(rowp + bj * 128) = w; } }
    }
};
struct EpiBf16Plain {
    static constexpr bool PERM = true, AFTER_DRAIN = false;
    bf16* O; int ldc;
    __device__ __forceinline__ void operator()(const pg8::f32x4 (&acc)[2][2][4][2], const pg8::Unit& u, int wr, int wc, int fr, int fq) const {
        const int row0 = u.pm * 256 + wr * 64 + fr, col0 = u.pn * 256 + wc * 32 + 8 * fq;
#pragma unroll
        for (int ai = 0; ai < 2; ++ai)
#pragma unroll
            for (int m = 0; m < 4; ++m) { bf16* rowp = O + (size_t)(row0 + ai * 128 + m * 16) * ldc + col0;
#pragma unroll
                for (int bj = 0; bj < 2; ++bj) { const f32x4 v0 = acc[ai][bj][m][0], v1 = acc[ai][bj][m][1];
                    u32x4 w; w.x = pk2(v0[0], v0[1]); w.y = pk2(v0[2], v0[3]); w.z = pk2(v1[0], v1[1]); w.w = pk2(v1[2], v1[3]);
                    *(u32x4*)(rowp + bj * 128) = w; } }
    }
};

__device__ __forceinline__ void transpose_item(const float* W, int K, int N, bf16* WT, int k0, int dst_row0, int src_col0, int nvalid, LAS float* scr, int lane, const float* kscale = nullptr) {
    const int col = lane & 31;
    float v[32];
#pragma unroll
    for (int i = 0; i < 32; ++i) { const int kk = 2 * i + (lane >> 5); v[i] = (col < nvalid) ? W[(size_t)(k0 + kk) * N + src_col0 + col] : 0.f; }
    if (kscale) {
#pragma unroll
        for (int i = 0; i < 32; ++i) v[i] *= kscale[k0 + 2 * i + (lane >> 5)]; }
#pragma unroll
    for (int i = 0; i < 32; ++i) { const int kk = 2 * i + (lane >> 5); scr[kk * 33 + col] = v[i]; }
    LDS_WAIT(); asm volatile("" ::: "memory");
    const int c = lane & 7;
#pragma unroll
    for (int j = 0; j < 4; ++j) { const int n = (lane >> 3) + 8 * j; const LAS float* s = scr + (8 * c) * 33 + n;
        u32x4 o; o.x = pk2(s[0 * 33], s[1 * 33]); o.y = pk2(s[2 * 33], s[3 * 33]); o.z = pk2(s[4 * 33], s[5 * 33]); o.w = pk2(s[6 * 33], s[7 * 33]);
        *(u32x4*)(WT + (size_t)(dst_row0 + n) * K + k0 + 8 * c) = o; }
    LDS_WAIT(); asm volatile("" ::: "memory");
}
__device__ __forceinline__ void rms_row_to_bf16(const float* xrow, const float* w, bf16* orow, int lane) {
    const f32x4* xr = (const f32x4*)xrow + lane; const f32x4* wr = (const f32x4*)w + lane;
    f32x4 v[8]; float s = 0.f;
#pragma unroll
    for (int j = 0; j < 8; ++j) { v[j] = xr[64 * j]; s += (v[j].x * v[j].x + v[j].y * v[j].y) + (v[j].z * v[j].z + v[j].w * v[j].w); }
    const float r = 1.0f / sqrtf(wave_sum(s) * (1.f / D_MODEL) + EPS);
    u32x2* o8 = (u32x2*)orow + lane;
#pragma unroll
    for (int j = 0; j < 8; ++j) { const f32x4 ww = wr[64 * j]; u32x2 o; o.x = pk2(v[j].x * r * ww.x, v[j].y * r * ww.y); o.y = pk2(v[j].z * r * ww.z, v[j].w * r * ww.w); o8[64 * j] = o; }
}
__device__ __forceinline__ void rms_row_to_f32(const float* xrow, const float* w, float* orow, int lane) {
    const f32x4* xr = (const f32x4*)xrow + lane; const f32x4* wr = (const f32x4*)w + lane;
    f32x4 v[8]; float s = 0.f;
#pragma unroll
    for (int j = 0; j < 8; ++j) { v[j] = xr[64 * j]; s += (v[j].x * v[j].x + v[j].y * v[j].y) + (v[j].z * v[j].z + v[j].w * v[j].w); }
    const float r = 1.0f / sqrtf(wave_sum(s) * (1.f / D_MODEL) + EPS);
    f32x4* o = (f32x4*)orow + lane;
#pragma unroll
    for (int j = 0; j < 8; ++j) { const f32x4 ww = wr[64 * j]; o[64 * j] = v[j] * r * ww; }
}
__device__ __forceinline__ void rms_row_add_to_f32(const bf16* xrow, const bf16* drow, const float* w, float* orow, int lane) {
    const u32x2* xr = (const u32x2*)xrow + lane; const f32x4* wr = (const f32x4*)w + lane; const u32x2* dr = (const u32x2*)drow + lane;
    f32x4 v[8]; float s = 0.f;
#pragma unroll
    for (int j = 0; j < 8; ++j) { const u32x2 d = dr[64 * j], xx = xr[64 * j]; v[j].x = bf_lo(xx.x) + bf_lo(d.x); v[j].y = bf_hi(xx.x) + bf_hi(d.x); v[j].z = bf_lo(xx.y) + bf_lo(d.y); v[j].w = bf_hi(xx.y) + bf_hi(d.y);
        s += (v[j].x * v[j].x + v[j].y * v[j].y) + (v[j].z * v[j].z + v[j].w * v[j].w); }
    const float r = 1.0f / sqrtf(wave_sum(s) * (1.f / D_MODEL) + EPS);
    f32x4* o = (f32x4*)orow + lane;
#pragma unroll
    for (int j = 0; j < 8; ++j) { const f32x4 ww = wr[64 * j]; o[64 * j] = v[j] * r * ww; }
}
__device__ __forceinline__ void convert_bf16(const float* src, bf16* dst, size_t n, size_t gtid, size_t gthreads) {
    const size_t n8 = n / 8;
    for (size_t i0 = gtid; i0 < n8; i0 += 4 * gthreads) {
        f32x4 a[4], b[4];
#pragma unroll
        for (int u = 0; u < 4; ++u) { const size_t i = i0 + u * gthreads; if (i < n8) { a[u] = __builtin_nontemporal_load((const f32x4*)(src + 8 * i)); b[u] = __builtin_nontemporal_load((const f32x4*)(src + 8 * i + 4)); } }
#pragma unroll
        for (int u = 0; u < 4; ++u) { const size_t i = i0 + u * gthreads; if (i < n8) { u32x4 o; o.x = pk2(a[u].x, a[u].y); o.y = pk2(a[u].z, a[u].w); o.z = pk2(b[u].x, b[u].y); o.w = pk2(b[u].z, b[u].w); *(u32x4*)(dst + 8 * i) = o; } }
    }
}

__device__ __forceinline__ unsigned pk4_fp8(f32x4 v, float sc) { int r = 0; r = __builtin_amdgcn_cvt_pk_fp8_f32(v.x * sc, v.y * sc, r, false); r = __builtin_amdgcn_cvt_pk_fp8_f32(v.z * sc, v.w * sc, r, true); return (unsigned)r; }
__device__ __forceinline__ unsigned pk4_i8(f32x4 v, float s) {
    const auto a = __builtin_amdgcn_cvt_pknorm_i16(v.x * s, v.y * s), b = __builtin_amdgcn_cvt_pknorm_i16(v.z * s, v.w * s);
    return __builtin_amdgcn_perm(__builtin_bit_cast(unsigned, b), __builtin_bit_cast(unsigned, a), 0x06040200u);
}
__device__ __forceinline__ void convert_i8_rows(const float* src, unsigned char* dst, float* usc, int gw, int NGW, int lane, const float* cscale, int e_begin = 0, int e_end = N_EXPERTS) {
    for (int e = e_begin + gw; e < e_end; e += NGW) {
        f32x4 a[8];
#pragma unroll
        for (int k = 0; k < 8; ++k) a[k] = __builtin_nontemporal_load((const f32x4*)(src + (size_t)e * D_MODEL) + k * 64 + lane);
        float mx = 0.f;
#pragma unroll
        for (int k = 0; k < 8; ++k) { a[k] = a[k] * *(const f32x4*)(cscale + 4 * (k * 64 + lane)); mx = fmaxf(fmaxf(fmaxf(fabsf(a[k].x), fabsf(a[k].y)), fmaxf(fabsf(a[k].z), fabsf(a[k].w))), mx); }
#pragma unroll
        for (int o = 1; o < 64; o <<= 1) mx = fmaxf(mx, __shfl_xor(mx, o));
        const float s = mx > 1e-30f ? (127.f / 32767.f) / mx : 0.f;
        if (lane == 0) usc[e] = mx * (1.f / 127.f);
#pragma unroll
        for (int k = 0; k < 8; ++k) { const int jd = k * 64 + lane, sl = jd >> 5, cd = jd & 31;
            *(unsigned*)(dst + ((size_t)sl * N_EXPERTS + e) * 128 + cd * 4) = pk4_i8(a[k], s); }
    }
}
__device__ __forceinline__ void convert_fp8_sliced(const float* src, unsigned char* dst, float sc, int gw, int NGW, int lane, const float* cscale = nullptr, int h_begin = 0, int h_end = N_EXPERTS * 2) {
    const int NHALF = h_end;
    for (int h0 = h_begin + gw; h0 < NHALF; h0 += 2 * NGW) {
        f32x4 a[2][4];
#pragma unroll
        for (int u = 0; u < 2; ++u) { const int hr = h0 + u * NGW; if (hr < NHALF) {
#pragma unroll
            for (int k = 0; k < 4; ++k) a[u][k] = __builtin_nontemporal_load((const f32x4*)(src + (size_t)hr * 1024) + k * 64 + lane); } }
#pragma unroll
        for (int u = 0; u < 2; ++u) { const int hr = h0 + u * NGW; if (hr < NHALF) {
            const int e = hr >> 1, hf = hr & 1;
#pragma unroll
            for (int k = 0; k < 4; ++k) { const int jd = hf * 256 + k * 64 + lane, sl = jd >> 5, cd = jd & 31;
                f32x4 v = a[u][k]; if (cscale) v = v * *(const f32x4*)(cscale + 4 * jd);
                *(unsigned*)(dst + ((size_t)sl * N_EXPERTS + e) * 128 + cd * 4) = pk4_fp8(v, sc); } } }
    }
}

__device__ __forceinline__ void phase_prologue(const Params& p, LAS unsigned char* lds, int tid, int lane, int wave) {
    unsigned char* ws = p.ws;
    LAS float* scr = (LAS float*)(lds + wave * 16384);
    const int gw = blockIdx.x * NWAVES + wave, NGW = gridDim.x * NWAVES;
    constexpr int IT_IN = 32 * (N_IN_PAD / 32), IT_SQ = 32 * 64, IT_WC = 64 * 4;
    constexpr int NITEMS = IT_IN + 2 * IT_SQ;
    for (int it = gw; it < NITEMS; it += NGW) {
        int r = it;
        if (r < IT_IN) { const int nb = r % (N_IN_PAD / 32), kb = r / (N_IN_PAD / 32); const int n0 = nb * 32;
            int src, nvalid = 32;
            if (n0 < 2560) src = n0; else if (n0 < 5632) src = n0 + 24; else { src = 2560 + (n0 - 5632); nvalid = (n0 == 5632) ? 24 : 0; if (nvalid == 0) src = 0; }
            transpose_item(p.in[I_WIN], D_MODEL, N_IN, (bf16*)(ws + WS_WIN_T), kb * 64, n0, src, nvalid, scr, lane); continue; }
        r -= IT_IN;
        if (r < IT_SQ) { transpose_item(p.in[I_WOUT], D_MODEL, D_MODEL, (bf16*)(ws + WS_WOUT_T), (r / 64) * 64, (r % 64) * 32, (r % 64) * 32, 32, scr, lane); continue; }
        r -= IT_SQ;
        transpose_item(p.in[I_PWQ], D_MODEL, D_MODEL, (bf16*)(ws + WS_WQ_T), (r / 64) * 64, (r % 64) * 32, (r % 64) * 32, 32, scr, lane, p.in[I_FNW]);
    }
    for (int ch = blockIdx.x * NTHREADS + tid; ch < 131072; ch += gridDim.x * NTHREADS) {
        const int ln = ch & 63, c = (ch >> 6) & 7, hh = (ch >> 9) & 1, pp = (ch >> 10) & 7, w = (ch >> 13) & 7, kv = ch >> 16;
        const int kk0 = 512 * w + 64 * pp + 16 * (ln >> 4) + 8 * hh, e = 16 * c + (ln & 15);
        const float* W = p.in[kv ? I_WCV : I_WCK] + (size_t)kk0 * 128 + e;
        u32x4 o; o.x = pk2(W[0], W[128]); o.y = pk2(W[256], W[384]); o.z = pk2(W[512], W[640]); o.w = pk2(W[768], W[896]);
        *((u32x4*)(ws + WS_WCK_T) + ch) = o;
    }
    for (int m = gw; m < T_TOK; m += NGW) rms_row_to_bf16(p.in[I_X] + (size_t)m * D_MODEL, p.in[I_ANW], (bf16*)(ws + WS_XN) + (size_t)m * D_MODEL, lane);
    const size_t gtid = (size_t)blockIdx.x * NTHREADS + tid, gthreads = (size_t)gridDim.x * NTHREADS;
    convert_i8_rows(p.in[I_PU], ws + WS_U, (float*)(ws + WS_USC), gw, NGW, lane, p.in[I_FNW], 0, U_ROWS_P0);
    if (V_HALF_P0 > 0) convert_fp8_sliced(p.in[I_PV], ws + WS_V, 256.f, gw, NGW, lane, nullptr, 0, V_HALF_P0);
    convert_bf16(p.in[I_PSK], (bf16*)(ws + WS_SK), (size_t)8 * 2 * 128 * 128, gtid, gthreads);
    for (int ub = blockIdx.x; ub < 256; ub += gridDim.x) {
        const int kv = ub & 1, j = ub >> 1;
        const float* W = p.in[kv == 0 ? I_WCK : I_WCV]; const float* cp = p.in[I_CPOS];
        const int e = tid & 127, sub = tid >> 7; float s = 0.f;
#pragma unroll
        for (int i = 0; i < 8; ++i) { const int kk = j * 32 + sub * 8 + i; s += cp[kk] * W[(size_t)kk * 128 + e]; }
        LAS float* red = (LAS float*)(lds + 8 * 16384);
        __syncthreads();
        red[tid] = s; __syncthreads();
        if (tid < 128) ((float*)(ws + WS_CCONST))[(j * 2 + kv) * 128 + tid] = (red[tid] + red[tid + 128]) + (red[tid + 256] + red[tid + 384]);
    }
}

__device__ __forceinline__ void conv_token(const Params& p, int m, int lane) {
    unsigned char* ws = p.ws;
    const bf16* BG = (const bf16*)(ws + WS_BG); const bf16* CG = (const bf16*)(ws + WS_CG); const bf16* HC = (const bf16*)(ws + WS_HC);
    const int s = m & (SEQ - 1), c0 = 16 * lane;
    float u[3][16];
#pragma unroll
    for (int k = 0; k < 3; ++k) {
        const int back = 2 - k;
        if (s - back >= 0) {
            const size_t o = (size_t)(m - back) * D_CONV + c0;
            const u32x4 ca = *(const u32x4*)(CG + o), cb = *(const u32x4*)(CG + o + 8), ha = *(const u32x4*)(HC + o), hb = *(const u32x4*)(HC + o + 8);
#pragma unroll
            for (int j = 0; j < 4; ++j) { u[k][2 * j] = bf_lo(ca[j]) * bf_lo(ha[j]); u[k][2 * j + 1] = bf_hi(ca[j]) * bf_hi(ha[j]);
                u[k][8 + 2 * j] = bf_lo(cb[j]) * bf_lo(hb[j]); u[k][8 + 2 * j + 1] = bf_hi(cb[j]) * bf_hi(hb[j]); }
        } else {
#pragma unroll
            for (int j = 0; j < 16; ++j) u[k][j] = 0.f;
        }
    }
    const float* cw = p.in[I_CW]; const float* cb = p.in[I_CB]; const float* gw = p.in[I_CGNW];
    const size_t o = (size_t)m * D_CONV + c0;
    const u32x4 ba = *(const u32x4*)(BG + o), bb = *(const u32x4*)(BG + o + 8);
    float bg[16];
#pragma unroll
    for (int j = 0; j < 4; ++j) { bg[2 * j] = bf_lo(ba[j]); bg[2 * j + 1] = bf_hi(ba[j]); bg[8 + 2 * j] = bf_lo(bb[j]); bg[8 + 2 * j + 1] = bf_hi(bb[j]); }
    float y[16]; float ss = 0.f;
#pragma unroll
    for (int j4 = 0; j4 < 4; ++j4) {
        const f32x4 w0 = *(const f32x4*)(cw + c0 + 4 * j4), w1 = *(const f32x4*)(cw + D_CONV + c0 + 4 * j4), w2 = *(const f32x4*)(cw + 2 * D_CONV + c0 + 4 * j4), bv = *(const f32x4*)(cb + c0 + 4 * j4);
#pragma unroll
        for (int j = 0; j < 4; ++j) { const int c = 4 * j4 + j; const float yy = (w0[j] * u[0][c] + w1[j] * u[1][c] + w2[j] * u[2][c] + bv[j]) * bg[c]; y[c] = yy; ss += yy * yy; }
    }
    ss += __shfl_xor(ss, 1); ss += __shfl_xor(ss, 2); ss += __shfl_xor(ss, 4);
    const float r = 1.0f / sqrtf(ss * (1.f / 128.f) + EPS);
    bf16* MX = (bf16*)(ws + WS_MIXED) + (size_t)m * D_MODEL + D_ATTN + c0;
    u32x4 o0, o1;
#pragma unroll
    for (int j4 = 0; j4 < 4; ++j4) { const f32x4 g = *(const f32x4*)(gw + c0 + 4 * j4);
        const unsigned a = pk2(y[4 * j4] * r * g[0], y[4 * j4 + 1] * r * g[1]), b = pk2(y[4 * j4 + 2] * r * g[2], y[4 * j4 + 3] * r * g[3]);
        if (j4 == 0) { o0.x = a; o0.y = b; } else if (j4 == 1) { o0.z = a; o0.w = b; } else if (j4 == 2) { o1.x = a; o1.y = b; } else { o1.z = a; o1.w = b; } }
    *(u32x4*)MX = o0; *(u32x4*)(MX + 8) = o1;
}
__device__ __forceinline__ void compress_unit(const Params& p, LAS unsigned char* lds, int unit, int tid, int lane, int wave) {
    unsigned char* ws = p.ws;
    const int nt = unit & 15, h = (unit >> 4) & 1, b = (unit >> 5) & 1, kv = unit >> 6;
    const bf16* src = (const bf16*)(ws + (kv ? WS_VC : WS_KC)) + (size_t)(b * 2 + h) * SEQ * 128;
    const int r = lane & 15, q = lane >> 4;
    int n = nt * 16 + r; if (n > 254) n = 254;
    const bf16* arow = src + (size_t)n * 16 * 128 + wave * 512 + 16 * q;
    const bf16x8* bfr = (const bf16x8*)(ws + WS_WCK_T) + ((size_t)(kv * 8 + wave) * 128) * 64 + lane;
    float ccv = 0.f;
    { const float* ccp = (const float*)(ws + WS_CCONST) + kv * 128 + (tid & 127);
      float c4[4] = {0.f, 0.f, 0.f, 0.f};
#pragma unroll
      for (int j = 0; j < 128; ++j) c4[j & 3] += ccp[j * 256];
      ccv = (c4[0] + c4[1]) + (c4[2] + c4[3]); }
    f32x4 acc[8];
#pragma unroll
    for (int c = 0; c < 8; ++c) acc[c] = (f32x4){0.f, 0.f, 0.f, 0.f};
#pragma unroll 2
    for (int pp = 0; pp < 8; ++pp) {
        const bf16x8 a0 = *(const bf16x8*)(arow + pp * 64), a1 = *(const bf16x8*)(arow + pp * 64 + 8);
        bf16x8 bb[16];
#pragma unroll
        for (int c = 0; c < 16; ++c) bb[c] = bfr[(size_t)(pp * 16 + c) * 64];
#pragma unroll
        for (int c = 0; c < 8; ++c) { acc[c] = __builtin_amdgcn_mfma_f32_16x16x32_bf16(a0, bb[c], acc[c], 0, 0, 0); acc[c] = __builtin_amdgcn_mfma_f32_16x16x32_bf16(a1, bb[8 + c], acc[c], 0, 0, 0); }
    }
    LAS float* red = (LAS float*)lds;
#pragma unroll
    for (int c = 0; c < 8; ++c)
#pragma unroll
        for (int j = 0; j < 4; ++j) red[wave * 2048 + (4 * q + j) * 128 + 16 * c + r] = acc[c][j];
    __syncthreads();
#pragma unroll
    for (int k = 0; k < 4; ++k) {
        const int o = tid + 512 * k, nn = o >> 7, e = o & 127;
        float s = 0.f;
#pragma unroll
        for (int w = 0; w < 8; ++w) s += red[w * 2048 + o];
        s += ccv;
        const int ng = nt * 16 + nn;
        if (ng > 254) s = 0.f;
        if (kv == 0) ((bf16*)(ws + WS_KCMP))[((size_t)(b * 2 + h) * 256 + ng) * 128 + e] = (bf16)f2bf(s);
        else ((bf16*)(ws + WS_VCMPT))[((size_t)(b * 2 + h) * 128 + e) * 256 + ng] = (bf16)f2bf(s);
    }
    __syncthreads();
}

constexpr int AT_KBUF = 16384, AT_VBUF = 128 * 128, AT_BUF = AT_KBUF + AT_VBUF;
constexpr int AT_OFF_IMP = 2 * AT_BUF;
constexpr int AT_OFF_SC = AT_OFF_IMP + 32768;
constexpr int AT_OFF_PARK = 2 * AT_BUF;
constexpr int AT_OFF_LUT = AT_OFF_PARK + 65536;
constexpr int AT_OFF_MASK = AT_OFF_LUT + 2048;
static_assert(AT_OFF_SC + 8192 <= AT_OFF_LUT && AT_OFF_MASK + 256 <= LDS_CTL_OFF, "attention LDS map");
typedef unsigned long long u64;

__device__ __forceinline__ void at_load_k(u32x4 (&kr)[2], const bf16* ktile, int tid) {
    const u32x4* s = (const u32x4*)(ktile + (size_t)(tid >> 3) * 128 + (tid & 7) * 16); kr[0] = s[0]; kr[1] = s[1];
}
__device__ __forceinline__ void at_store_k(const u32x4 (&kr)[2], LAS unsigned char* kb, int tid) {
    const int row = tid >> 3, c0 = (tid & 7) * 2, sk = (row & 3) | (((row >> 3) & 3) << 2);
    *(LAS u32x4*)(kb + row * 256 + (((c0) ^ sk) << 4)) = kr[0];
    *(LAS u32x4*)(kb + row * 256 + (((c0 + 1) ^ sk) << 4)) = kr[1];
}
__device__ __forceinline__ void at_load_v(u32x4 (&vr)[2], const bf16* vt, size_t vstride, int tid) {
    const u32x4* s = (const u32x4*)(vt + (size_t)(tid >> 2) * vstride + (tid & 3) * 16); vr[0] = s[0]; vr[1] = s[1];
}
__device__ __forceinline__ void at_store_v(const u32x4 (&vr)[2], LAS unsigned char* vb, int tid) {
    const int row = tid >> 2, c0 = (tid & 3) * 2, f = (row >> 1) & 7;
    *(LAS u32x4*)(vb + row * 128 + ((c0 ^ f) << 4)) = vr[0];
    *(LAS u32x4*)(vb + row * 128 + (((c0 + 1) ^ f) << 4)) = vr[1];
}
__device__ __forceinline__ void at_qk_load(const LAS unsigned char* kb, bf16x8 (&a)[16], int r, int q) {
#pragma unroll
    for (int ks = 0; ks < 4; ++ks)
#pragma unroll
        for (int mt = 0; mt < 4; ++mt)
            a[4 * ks + mt] = *(const LAS bf16x8*)(kb + (32 * (mt >> 1) + 8 * (r >> 2) + 4 * (mt & 1) + (r & 3)) * 256 + (((4 * ks + q) ^ r) << 4));
}
__device__ __forceinline__ void at_qk_mma(const bf16x8 (&a)[16], const bf16x8 (&Qf)[4], f32x4 (&S)[4], float c0) {
#pragma unroll
    for (int mt = 0; mt < 4; ++mt) S[mt] = (f32x4){c0, c0, c0, c0};
#pragma unroll
    for (int ks = 0; ks < 4; ++ks)
#pragma unroll
        for (int mt = 0; mt < 4; ++mt) S[mt] = __builtin_amdgcn_mfma_f32_16x16x32_bf16(a[4 * ks + mt], Qf[ks], S[mt], 0, 0, 0);
}
__device__ __forceinline__ void at_qk(const LAS unsigned char* kb, const bf16x8 (&Qf)[4], f32x4 (&S)[4], int r, int q, float c0 = 0.f) {
    bf16x8 a[16];
    at_qk_load(kb, a, r, q);
    __builtin_amdgcn_sched_barrier(0);
    at_qk_mma(a, Qf, S, c0);
}
__device__ __forceinline__ void at_pv_load(const LAS unsigned char* vb, bf16x8 (&v)[16], int r, int q) {
#pragma unroll
    for (int k2 = 0; k2 < 2; ++k2)
#pragma unroll
        for (int dt = 0; dt < 8; ++dt)
            v[8 * k2 + dt] = *(const LAS bf16x8*)(vb + (16 * dt + r) * 128 + (((4 * k2 + q) ^ ((r >> 1) & 7)) << 4));
}
__device__ __forceinline__ void at_pv_mma(const bf16x8 (&v)[16], const f32x4 (&P)[4], f32x4 (&O)[8]) {
    bf16x8 pf[2];
#pragma unroll
    for (int k2 = 0; k2 < 2; ++k2) {
        u32x4 w; w.x = pk2(P[2 * k2][0], P[2 * k2][1]); w.y = pk2(P[2 * k2][2], P[2 * k2][3]); w.z = pk2(P[2 * k2 + 1][0], P[2 * k2 + 1][1]); w.w = pk2(P[2 * k2 + 1][2], P[2 * k2 + 1][3]);
        pf[k2] = __builtin_bit_cast(bf16x8, w);
    }
#pragma unroll
    for (int k2 = 0; k2 < 2; ++k2)
#pragma unroll
        for (int dt = 0; dt < 8; ++dt) O[dt] = __builtin_amdgcn_mfma_f32_16x16x32_bf16(v[8 * k2 + dt], pf[k2], O[dt], 0, 0, 0);
}
__device__ __forceinline__ void at_pv(const LAS unsigned char* vb, const f32x4 (&P)[4], f32x4 (&O)[8], int r, int q) {
    bf16x8 v[16];
    at_pv_load(vb, v, r, q);
    __builtin_amdgcn_sched_barrier(0);
    at_pv_mma(v, P, O);
}
__device__ __forceinline__ float at_u2f(unsigned u) { return __builtin_bit_cast(float, u); }
__device__ __forceinline__ unsigned at_f2u(float f) { return __builtin_bit_cast(unsigned, f); }
__device__ __forceinline__ float quad_max(float v) {
    const auto a = __builtin_amdgcn_permlane32_swap(at_f2u(v), at_f2u(v), false, false); const unsigned a0 = a[0], a1 = a[1];
    const float m = fmaxf(at_u2f(a0), at_u2f(a1));
    const auto b = __builtin_amdgcn_permlane16_swap(at_f2u(m), at_f2u(m), false, false); const unsigned b0 = b[0], b1 = b[1];
    return fmaxf(at_u2f(b0), at_u2f(b1));
}
__device__ __forceinline__ float quad_sum(float v) {
    const auto a = __builtin_amdgcn_permlane32_swap(at_f2u(v), at_f2u(v), false, false); const unsigned a0 = a[0], a1 = a[1];
    const float m = at_u2f(a0) + at_u2f(a1);
    const auto b = __builtin_amdgcn_permlane16_swap(at_f2u(m), at_f2u(m), false, false); const unsigned b0 = b[0], b1 = b[1];
    return at_u2f(b0) + at_u2f(b1);
}

__device__ __forceinline__ void at_gld16(u32x4& d, unsigned voff, const void* sbase) { asm volatile("global_load_dwordx4 %0, %1, %2" : "=v"(d) : "v"(voff), "s"(sbase) : "memory"); }
template <int N> __device__ __forceinline__ void at_vmwait(u32x4& a, u32x4& b, u32x4& c, u32x4& d) { asm volatile("s_waitcnt vmcnt(%4)" : "+v"(a), "+v"(b), "+v"(c), "+v"(d) : "n"(N) : "memory"); }
__device__ __forceinline__ void at_issue_tile(u32x4 (&kr)[2], u32x4 (&vr)[2], const bf16* Kg, const bf16* Vtg, int j, unsigned koff, unsigned voff) {
    j = __builtin_amdgcn_readfirstlane(j);
    const void* kb = Kg + (size_t)j * 64 * 128; const void* vb = Vtg + (size_t)j * 64;
    at_gld16(kr[0], koff, kb); at_gld16(kr[1], koff + 16u, kb); at_gld16(vr[0], voff, vb); at_gld16(vr[1], voff + 16u, vb);
}
template <int MODE> __device__ __forceinline__ int at_next(int j, int j_hi, u64 active) {
    int jn = j + 1;
    if (MODE == 0) { while (jn <= j_hi && !((active >> jn) & 1ull)) ++jn; }
    return jn;
}
constexpr float AT_THR = 8.0f;
template <int MODE>
__device__ __forceinline__ void at_tile(LAS unsigned char* lds, int stage, int j, u64 mymask, u64 wavemask, int t, int tw_min, const LAS float* lut, const bf16x8 (&Qf)[4], f32x4 (&O)[8], float& m, float& l, int r, int q) {
    if (MODE == 0 && !((wavemask >> j) & 1ull)) return;
    const LAS unsigned char* kb = lds + stage * AT_BUF; const LAS unsigned char* vb = kb + AT_KBUF;
    const bool rowok = (MODE == 0) ? (((mymask >> j) & 1ull) != 0ull) : true;
    const bool far = (tw_min - (64 * j + 63) >= 127) && (MODE == 0 || (tw_min + 3 - 64 * j) < 512);
    f32x4 S[4];
    if (far) {
        at_qk(kb, Qf, S, r, q, rowok ? lut[127] - m : -INFINITY);
    } else {
        at_qk(kb, Qf, S, r, q);
        const int d0 = t - 64 * j - 8 * q;
#pragma unroll
        for (int mt = 0; mt < 4; ++mt)
#pragma unroll
            for (int jj = 0; jj < 4; ++jj) {
                const int dist = d0 - (32 * (mt >> 1) + 4 * (mt & 1)) - jj;
                const bool ok = rowok && dist >= 0 && (MODE == 0 || dist < 512);
                const int di = dist < 0 ? 0 : (dist > 127 ? 127 : dist);
                const float bv = ((const volatile LAS float*)lut)[di];
                S[mt][jj] = ok ? S[mt][jj] + (bv - m) : -INFINITY;
            }
    }
    float mx = -INFINITY;
#pragma unroll
    for (int mt = 0; mt < 4; ++mt) mx = fmaxf(fmaxf(fmaxf(S[mt][0], S[mt][1]), fmaxf(S[mt][2], S[mt][3])), mx);
    if (__builtin_amdgcn_ballot_w64(mx > AT_THR) != 0ull) {
        const float up = fmaxf(quad_max(mx), 0.f);
        const float f = __builtin_amdgcn_exp2f(-up);
        m += up; l *= f;
#pragma unroll
        for (int dt = 0; dt < 8; ++dt) O[dt] = O[dt] * f;
#pragma unroll
        for (int mt = 0; mt < 4; ++mt) S[mt] = S[mt] - up;
    }
    float ps = 0.f;
#pragma unroll
    for (int mt = 0; mt < 4; ++mt)
#pragma unroll
        for (int jj = 0; jj < 4; ++jj) { const float pv = __builtin_amdgcn_exp2f(S[mt][jj]); S[mt][jj] = pv; ps += pv; }
    l += ps;
    at_pv(vb, S, O, r, q);
}
template <int MODE>
__device__ __forceinline__ void attn_branch(LAS unsigned char* lds, const bf16* Kg, const bf16* Vtg, int j_lo, int j_hi, u64 active, u64 mymask, u64 wavemask, int t, int g,
                                            const bf16x8 (&Qf)[4], f32x4 (&O)[8], float& m, float& l, int tid, int r, int q) {
    asm volatile("" : "+v"(tid), "+v"(r), "+v"(q));
    const LAS float* lut = (const LAS float*)(lds + AT_OFF_LUT) + g * 128;
    const int tw_min = t - (r >> 2);
    wavemask = ((u64)(unsigned)__builtin_amdgcn_readfirstlane((int)(unsigned)(wavemask >> 32)) << 32) | (unsigned)__builtin_amdgcn_readfirstlane((int)(unsigned)wavemask);
    active = ((u64)(unsigned)__builtin_amdgcn_readfirstlane((int)(unsigned)(active >> 32)) << 32) | (unsigned)__builtin_amdgcn_readfirstlane((int)(unsigned)active);
    j_lo = __builtin_amdgcn_readfirstlane(j_lo); j_hi = __builtin_amdgcn_readfirstlane(j_hi);
    const int w = __builtin_amdgcn_readfirstlane(tid >> 6), ln = tid & 63;
    unsigned kof[2], vof[2];
#pragma unroll
    for (int i = 0; i < 2; ++i) {
        const int kr = 8 * w + 4 * i + (ln >> 4), sk = (kr & 3) | (((kr >> 3) & 3) << 2); kof[i] = (unsigned)((kr * 128 + (((ln & 15) ^ sk) << 3)) * 2);
        const int vr = 16 * w + 8 * i + (ln >> 3), f = (vr >> 1) & 7; vof[i] = (unsigned)((vr * SEQ + (((ln & 7) ^ f) << 3)) * 2);
    }
    const int kl = 8 * w * 256, vl = AT_KBUF + 16 * w * 128;
#define AT_DMA(stage, j) do { const char* kb_ = (const char*)(Kg + (size_t)(j) * 64 * 128); const char* vb_ = (const char*)(Vtg + (size_t)(j) * 64); \
        _Pragma("unroll") for (int i_ = 0; i_ < 2; ++i_) __builtin_amdgcn_global_load_lds((const unsigned*)(kb_ + kof[i_]), (LAS unsigned*)(lds + (stage) * AT_BUF + kl + i_ * 1024), 16, 0, 0); \
        _Pragma("unroll") for (int i_ = 0; i_ < 2; ++i_) __builtin_amdgcn_global_load_lds((const unsigned*)(vb_ + vof[i_]), (LAS unsigned*)(lds + (stage) * AT_BUF + vl + i_ * 1024), 16, 0, 0); } while (0)
    int j0 = j_lo, j1;
    AT_DMA(0, j0);
    for (;;) {
        asm volatile("s_waitcnt vmcnt(0)" ::: "memory");
        __syncthreads();
        j1 = at_next<MODE>(j0, j_hi, active);
        if (j1 <= j_hi) AT_DMA(1, j1);
        at_tile<MODE>(lds, 0, j0, mymask, wavemask, t, tw_min, lut, Qf, O, m, l, r, q);
        if (j1 > j_hi) break;
        j0 = j1;
        asm volatile("s_waitcnt vmcnt(0)" ::: "memory");
        __syncthreads();
        j1 = at_next<MODE>(j0, j_hi, active);
        if (j1 <= j_hi) AT_DMA(0, j1);
        at_tile<MODE>(lds, 1, j0, mymask, wavemask, t, tw_min, lut, Qf, O, m, l, r, q);
        if (j1 > j_hi) break;
        j0 = j1;
    }
#undef AT_DMA
    __syncthreads();
}

__device__ __forceinline__ void attn_unit(const Params& p, LAS unsigned char* lds, int unit, int tid, int lane, int wave) {
    asm volatile("" : "+v"(tid), "+v"(lane));
    unsigned char* ws = p.ws;
    const int bh = unit & 3, qt = 127 - (unit >> 2), b = bh >> 1, h = bh & 1;
    const int T0 = qt * 32, jt = T0 >> 6;
    const int r = lane & 15, q = lane >> 4, g = r & 3;
    const int tok = 4 * wave + (r >> 2), t = T0 + tok;
    const size_t mrow = (size_t)b * SEQ + t;
    const int hq = h * 4 + g;
    const int kt_max = (T0 >> 4) >> 6;
    const int dw = __builtin_amdgcn_readfirstlane(tid >> 6);
    unsigned ckof[2], cvof[2];
#pragma unroll
    for (int i = 0; i < 2; ++i) {
        const int kr = 8 * dw + 4 * i + (lane >> 4), sk = (kr & 3) | (((kr >> 3) & 3) << 2); ckof[i] = (unsigned)((kr * 128 + (((lane & 15) ^ sk) << 3)) * 2);
        const int vr = 16 * dw + 8 * i + (lane >> 3), f = (vr >> 1) & 7; cvof[i] = (unsigned)((vr * 256 + (((lane & 7) ^ f) << 3)) * 2);
    }
    {
        const char* Kc = (const char*)((const bf16*)(ws + WS_KCMP) + (size_t)bh * 256 * 128);
#pragma unroll
        for (int kt = 0; kt < 4; ++kt) if (kt <= kt_max) {
#pragma unroll
            for (int i = 0; i < 2; ++i) __builtin_amdgcn_global_load_lds((const unsigned*)(Kc + (size_t)kt * 64 * 128 * 2 + ckof[i]), (LAS unsigned*)(lds + kt * 16384 + 8 * dw * 256 + i * 1024), 16, 0, 0); }
    }
    {
        const int gg = tid >> 7, d = tid & 127;
        int bk = d;
        if (d >= 16) { bk = 16 + (d >= 19) + (d >= 21) + (d >= 24) + (d >= 27) + (d >= 31) + (d >= 35) + (d >= 40) + (d >= 46) + (d >= 52) + (d >= 59) + (d >= 67) + (d >= 77) + (d >= 87) + (d >= 99) + (d >= 113); }
        ((LAS float*)(lds + AT_OFF_LUT))[tid] = p.in[I_RB][bk * 8 + h * 4 + gg] * 1.4426950408889634f;
    }
    bf16x8 Qf[4];
    {
        const bf16* qp = (const bf16*)(ws + WS_Q) + mrow * D_ATTN + hq * 128 + 8 * q;
#pragma unroll
        for (int ks = 0; ks < 4; ++ks) Qf[ks] = *(const bf16x8*)(qp + 32 * ks);
    }
    const float* gl = (const float*)(ws + WS_GL) + mrow * 32 + hq * 3;
    const float gate_c = 1.f / (1.f + __expf(-gl[0])), gate_s = 1.f / (1.f + __expf(-gl[1])), gate_w = 1.f / (1.f + __expf(-gl[2]));
    f32x4 Otot[8];
    {
        const char* Vc = (const char*)((const bf16*)(ws + WS_VCMPT) + (size_t)bh * 128 * 256);
        const LAS float* lut = (const LAS float*)(lds + AT_OFF_LUT) + g * 128;
        f32x4 SA[4][4];
        asm volatile("s_waitcnt vmcnt(0)" ::: "memory");
        __syncthreads();
#pragma unroll
        for (int kt = 0; kt < 4; ++kt) {
            if (kt <= kt_max) at_qk(lds + kt * 16384, Qf, SA[kt], r, q);
            else {
#pragma unroll
                for (int mt = 0; mt < 4; ++mt) SA[kt][mt] = (f32x4){-INFINITY, -INFINITY, -INFINITY, -INFINITY};
            }
        }
        __syncthreads();
#pragma unroll
        for (int kt = 0; kt < 4; ++kt) if (kt <= kt_max) {
#pragma unroll
            for (int i = 0; i < 2; ++i) __builtin_amdgcn_global_load_lds((const unsigned*)(Vc + (size_t)kt * 64 * 2 + cvof[i]), (LAS unsigned*)(lds + kt * 16384 + 16 * dw * 128 + i * 1024), 16, 0, 0); }
        float mx = -INFINITY;
#pragma unroll
        for (int kt = 0; kt < 4; ++kt)
#pragma unroll
            for (int mt = 0; mt < 4; ++mt)
#pragma unroll
                for (int jj = 0; jj < 4; ++jj) {
                    const int n = 64 * kt + 32 * (mt >> 1) + 8 * q + 4 * (mt & 1) + jj, dist = t - 16 * n - 31;
                    const int di = dist < 0 ? 0 : (dist > 127 ? 127 : dist);
                    const float s = (dist >= 0) ? SA[kt][mt][jj] + lut[di] : -INFINITY;
                    SA[kt][mt][jj] = s; mx = fmaxf(mx, s);
                }
        mx = quad_max(mx);
        const float ms = (mx == -INFINITY) ? 0.f : mx;
        float ps = 0.f;
#pragma unroll
        for (int kt = 0; kt < 4; ++kt)
#pragma unroll
            for (int mt = 0; mt < 4; ++mt)
#pragma unroll
                for (int jj = 0; jj < 4; ++jj) { const float e = __builtin_amdgcn_exp2f(SA[kt][mt][jj] - ms); SA[kt][mt][jj] = e; ps += e; }
        ps = quad_sum(ps);
        const float inv = ps > 0.f ? 1.f / ps : 1.f;
        LAS float* impw = (LAS float*)(lds + AT_OFF_IMP) + (g * 32 + tok) * 64 + 2 * q;
        float prevB = 0.f;
#pragma unroll
        for (int kt = 0; kt < 4; ++kt)
#pragma unroll
            for (int pr = 0; pr < 2; ++pr) {
                SA[kt][2 * pr] = SA[kt][2 * pr] * inv; SA[kt][2 * pr + 1] = SA[kt][2 * pr + 1] * inv;
                const f32x4 pe = SA[kt][2 * pr], po = SA[kt][2 * pr + 1];
                const float Ae = (pe[0] + pe[1]) + (pe[2] + 0.5f * pe[3]), Be = 0.5f * pe[3];
                const float Ao = (po[0] + po[1]) + (po[2] + 0.5f * po[3]), Bo = 0.5f * po[3];
                const float snd = (q == 3) ? prevB : Bo;
                const float rcv = __shfl(snd, (lane - 16) & 63);
                impw[16 * kt + 8 * pr] = Ae + rcv;
                impw[16 * kt + 8 * pr + 1] = Ao + Be;
                prevB = Bo;
            }
        f32x4 O[8];
#pragma unroll
        for (int dt = 0; dt < 8; ++dt) O[dt] = (f32x4){0.f, 0.f, 0.f, 0.f};
        asm volatile("s_waitcnt vmcnt(0)" ::: "memory");
        __syncthreads();
#pragma unroll
        for (int kt = 0; kt < 4; ++kt) if (kt <= kt_max) at_pv(lds + kt * 16384, SA[kt], O, r, q);
        __syncthreads();
#pragma unroll
        for (int dt = 0; dt < 8; ++dt) Otot[dt] = O[dt] * gate_c;
    }
    {
        const LAS float* imp = (const LAS float*)(lds + AT_OFF_IMP);
        LAS float* sc = (LAS float*)(lds + AT_OFF_SC);
#pragma unroll
        for (int k = 0; k < 4; ++k) {
            const int cell = tid + 512 * k, tk = cell >> 6, jb = cell & 63;
            float v;
            if (jb == 0 || jb == jt || jb == jt - 1) v = 5.0f;
            else if (jb <= jt) v = ((imp[(0 * 32 + tk) * 64 + jb] + imp[(1 * 32 + tk) * 64 + jb]) + imp[(2 * 32 + tk) * 64 + jb]) + imp[(3 * 32 + tk) * 64 + jb];
            else v = -1.0f;
            sc[cell] = v;
        }
        __syncthreads();
        LAS u64* masks = (LAS u64*)(lds + AT_OFF_MASK);
#pragma unroll
        for (int k = 0; k < 4; ++k) {
            const int tk = wave * 4 + k;
            const float mine = sc[tk * 64 + lane];
            int cnt = 0;
            for (int jb = 0; jb < 64; ++jb) { const float o = sc[tk * 64 + jb]; cnt += (o > mine || (o == mine && jb < lane)) ? 1 : 0; }
            const u64 mk = __ballot(cnt < 16);
            if (lane == 0) masks[tk] = mk;
        }
        __syncthreads();
    }
    u64 mymask, active, wavemask;
    LAS f32x4* const park = (LAS f32x4*)(lds + AT_OFF_PARK) + wave * 512 + lane;
#pragma unroll
    for (int dt = 0; dt < 8; ++dt) park[64 * dt] = Otot[dt];
    {
        const LAS u64* masks = (const LAS u64*)(lds + AT_OFF_MASK);
        mymask = masks[tok];
        wavemask = (masks[4 * wave] | masks[4 * wave + 1]) | (masks[4 * wave + 2] | masks[4 * wave + 3]);
        u64 a = masks[lane & 31];
#pragma unroll
        for (int o = 1; o < 32; o <<= 1) { const unsigned lo = __shfl_xor((unsigned)a, o), hi = __shfl_xor((unsigned)(a >> 32), o); a |= ((u64)hi << 32) | lo; }
        active = a;
    }
    {
        f32x4 O[8];
#pragma unroll
        for (int dt = 0; dt < 8; ++dt) O[dt] = (f32x4){0.f, 0.f, 0.f, 0.f};
        float m = 0.f, l = 0.f;
        attn_branch<0>(lds, (const bf16*)(ws + WS_KS) + (size_t)bh * SEQ * 128, (const bf16*)(ws + WS_VST) + (size_t)bh * 128 * SEQ, 0, jt, active, mymask, wavemask, t, g, Qf, O, m, l, tid, r, q);
        l = quad_sum(l);
        const float sc = l > 0.f ? gate_s / l : 0.f;
#pragma unroll
        for (int dt = 0; dt < 8; ++dt) park[64 * dt] = park[64 * dt] + O[dt] * sc;
    }
    {
        f32x4 O[8];
#pragma unroll
        for (int dt = 0; dt < 8; ++dt) O[dt] = (f32x4){0.f, 0.f, 0.f, 0.f};
        float m = 0.f, l = 0.f;
        const int lo_pos = T0 - 511; const int j_lo = lo_pos <= 0 ? 0 : (lo_pos >> 6);
        attn_branch<1>(lds, (const bf16*)(ws + WS_KW) + (size_t)bh * SEQ * 128, (const bf16*)(ws + WS_VWT) + (size_t)bh * 128 * SEQ, j_lo, jt, ~0ull, ~0ull, ~0ull, t, g, Qf, O, m, l, tid, r, q);
        l = quad_sum(l);
        const float sc = l > 0.f ? gate_w / l : 0.f;
#pragma unroll
        for (int dt = 0; dt < 8; ++dt) Otot[dt] = park[64 * dt] + O[dt] * sc;
    }
    {
        float ss = 0.f;
#pragma unroll
        for (int dt = 0; dt < 8; ++dt) ss += (Otot[dt][0] * Otot[dt][0] + Otot[dt][1] * Otot[dt][1]) + (Otot[dt][2] * Otot[dt][2] + Otot[dt][3] * Otot[dt][3]);
        ss = quad_sum(ss);
        const float rn = 1.0f / sqrtf(ss * (1.f / 128.f) + EPS);
        const float* gw = p.in[I_AGNW] + hq * 128 + 4 * q;
        bf16* mx = (bf16*)(ws + WS_MIXED) + mrow * D_MODEL + hq * 128 + 4 * q;
#pragma unroll
        for (int dt = 0; dt < 8; ++dt) { const f32x4 w = *(const f32x4*)(gw + 16 * dt);
            u32x2 o; o.x = pk2(Otot[dt][0] * rn * w[0], Otot[dt][1] * rn * w[1]); o.y = pk2(Otot[dt][2] * rn * w[2], Otot[dt][3] * rn * w[3]);
            *(u32x2*)(mx + 16 * dt) = o; }
    }
}
__device__ __forceinline__ unsigned ord_key(float v) { const unsigned u = __builtin_bit_cast(unsigned, v); return (u & 0x80000000u) ? ~u : (u | 0x80000000u); }
__device__ __forceinline__ float ord_val(unsigned k) { const unsigned u = (k & 0x80000000u) ? (k & 0x7fffffffu) : ~k; return __builtin_bit_cast(float, u); }
#define PK_INSERT16(key) do { unsigned _k = (key); _Pragma("unroll") for (int _i = 0; _i < 16; ++_i) { const unsigned _hi = top[_i] > _k ? top[_i] : _k; _k = top[_i] > _k ? _k : top[_i]; top[_i] = _hi; } } while (0)
#define PK_CE(a, b) do { const unsigned _x = (a) > (b) ? (a) : (b); const unsigned _y = (a) > (b) ? (b) : (a); (a) = _x; (b) = _y; } while (0)
#define PK_MERGE(xm) do { unsigned _o[16]; _Pragma("unroll") for (int _i = 0; _i < 16; ++_i) _o[_i] = (unsigned)__shfl_xor((int)top[15 - _i], xm); \
    _Pragma("unroll") for (int _i = 0; _i < 16; ++_i) top[_i] = top[_i] > _o[_i] ? top[_i] : _o[_i]; \
    _Pragma("unroll") for (int _s = 8; _s >= 1; _s >>= 1) { _Pragma("unroll") for (int _i = 0; _i < 16; ++_i) if ((_i & _s) == 0) PK_CE(top[_i], top[_i + _s]); } } while (0)

#define PK_SORT16(a) do { _Pragma("unroll") for (int _k = 2; _k <= 16; _k <<= 1) { _Pragma("unroll") for (int _j = _k >> 1; _j > 0; _j >>= 1) { _Pragma("unroll") for (int _i = 0; _i < 16; ++_i) { \
    const int _l = _i ^ _j; if (_l > _i) { if ((_i & _k) == 0) PK_CE((a)[_i], (a)[_l]); else PK_CE((a)[_l], (a)[_i]); } } } } } while (0)
#define PK_TOP16_OF_32(a) do { PK_SORT16(a); PK_SORT16((a) + 16); \
    _Pragma("unroll") for (int _i = 0; _i < 16; ++_i) (a)[_i] = (a)[_i] > (a)[31 - _i] ? (a)[_i] : (a)[31 - _i]; \
    _Pragma("unroll") for (int _s = 8; _s >= 1; _s >>= 1) { _Pragma("unroll") for (int _i = 0; _i < 16; ++_i) if ((_i & _s) == 0) PK_CE((a)[_i], (a)[_i + _s]); } } while (0)
__device__ __forceinline__ void peer_topk_pass(const Params& p, LAS unsigned char* lds, int pass, int tid, int lane, int wave) {
    unsigned char* ws = p.ws;
    const int t0 = pass * 32, r = lane & 15, q = lane >> 4;
    LAS unsigned* lists = (LAS unsigned*)lds;
    const bf16* PQ = (const bf16*)(ws + WS_PQ);
    const bf16* SK = (const bf16*)(ws + WS_SK);
#pragma unroll 1
    for (int k = 0; k < 2; ++k) {
        const int hc = wave * 2 + k;
        bf16x8 bq0[4], bq1[4];
        const bf16* qp = PQ + (size_t)(t0 + r) * D_MODEL + hc * 128 + 8 * q;
#pragma unroll
        for (int ks = 0; ks < 4; ++ks) { bq0[ks] = *(const bf16x8*)(qp + 32 * ks); bq1[ks] = *(const bf16x8*)(qp + (size_t)16 * D_MODEL + 32 * ks); }
        const bf16* ap = SK + (size_t)hc * 128 * 128 + (size_t)r * 128 + 8 * q;
        unsigned ka[32], kb[32];
        bf16x8 ac[4], an[4];
#pragma unroll
        for (int ks = 0; ks < 4; ++ks) ac[ks] = *(const bf16x8*)(ap + 32 * ks);
#pragma unroll
        for (int mt = 0; mt < 8; ++mt) {
            if (mt < 7) {
#pragma unroll
                for (int ks = 0; ks < 4; ++ks) an[ks] = *(const bf16x8*)(ap + (size_t)(mt + 1) * 16 * 128 + 32 * ks);
            }
            f32x4 s0 = {0.f, 0.f, 0.f, 0.f}, s1 = {0.f, 0.f, 0.f, 0.f};
#pragma unroll
            for (int ks = 0; ks < 4; ++ks) { s0 = __builtin_amdgcn_mfma_f32_16x16x32_bf16(ac[ks], bq0[ks], s0, 0, 0, 0); s1 = __builtin_amdgcn_mfma_f32_16x16x32_bf16(ac[ks], bq1[ks], s1, 0, 0, 0); }
#pragma unroll
            for (int j = 0; j < 4; ++j) { const unsigned nidx = (unsigned)(127 - (16 * mt + 4 * q + j));
                ka[4 * mt + j] = (ord_key(s0[j]) & ~127u) | nidx; kb[4 * mt + j] = (ord_key(s1[j]) & ~127u) | nidx; }
            if (mt < 7) {
#pragma unroll
                for (int ks = 0; ks < 4; ++ks) ac[ks] = an[ks];
            }
        }
        unsigned top[16];
        PK_TOP16_OF_32(ka);
#pragma unroll
        for (int i = 0; i < 16; ++i) top[i] = ka[i];
        PK_MERGE(16); PK_MERGE(32);
        if (q == 0) { LAS unsigned* o = lists + (r * 16 + hc) * 16;
#pragma unroll
            for (int i = 0; i < 16; ++i) o[i] = top[i]; }
        PK_TOP16_OF_32(kb);
#pragma unroll
        for (int i = 0; i < 16; ++i) top[i] = kb[i];
        PK_MERGE(16); PK_MERGE(32);
        if (q == 0) { LAS unsigned* o = lists + ((16 + r) * 16 + hc) * 16;
#pragma unroll
            for (int i = 0; i < 16; ++i) o[i] = top[i]; }
    }
    __syncthreads();
#pragma unroll 1
    for (int rr = 0; rr < 2; ++rr) {
        const int row = rr * 128 + (tid >> 2), c = tid & 3, tl = row >> 3, hh = row & 7;
        const LAS unsigned* l0 = lists + (tl * 16 + hh * 2) * 16; const LAS unsigned* l1 = l0 + 16;
        unsigned top[16];
#pragma unroll
        for (int i = 0; i < 16; ++i) top[i] = 0u;
#pragma unroll 1
        for (int k = c; k < 50; k += 4) {
            int ci = (k >= 16) + (k >= 24) + (k >= 29) + (k >= 33) + (k >= 36) + (k >= 38) + (k >= 40) + (k >= 42);
            ci += (k >= 43) ? (k - 42) : 0;
            const int st = ci == 0 ? 0 : ci == 1 ? 16 : ci == 2 ? 24 : ci == 3 ? 29 : ci == 4 ? 33 : ci == 5 ? 36 : ci == 6 ? 38 : ci == 7 ? 40 : (34 + ci);
            const int cj = k - st;
            const float v = ord_val(l0[ci] & ~127u) + ord_val(l1[cj] & ~127u);
            PK_INSERT16((ord_key(v) & ~255u) | (unsigned)(255 - (ci * 16 + cj)));
        }
        PK_MERGE(1); PK_MERGE(2);
        if (c == 0) {
            float cv[16]; int ex[16]; float mx = -INFINITY;
#pragma unroll
            for (int i = 0; i < 16; ++i) { const int ci = 255 - (int)(top[i] & 255u), ii = ci >> 4, jj = ci & 15;
                const unsigned ka = l0[ii], kb = l1[jj];
                cv[i] = ord_val(ka & ~127u) + ord_val(kb & ~127u); mx = fmaxf(mx, cv[i]);
                ex[i] = (127 - (int)(ka & 127u)) * 128 + (127 - (int)(kb & 127u)); }
            float sum = 0.f;
#pragma unroll
            for (int i = 0; i < 16; ++i) { cv[i] = __expf(cv[i] - mx); sum += cv[i]; }
            const float inv = 1.f / sum;
            int* eo = (int*)(ws + WS_EIDX) + (size_t)(t0 + tl) * 128 + hh * 16; float* go = (float*)(ws + WS_EW) + (size_t)(t0 + tl) * 128 + hh * 16;
#pragma unroll
            for (int i = 0; i < 16; ++i) { eo[i] = ex[i]; go[i] = cv[i] * inv; }
        }
    }
    __syncthreads();
}

constexpr int NSLICE = 16;
constexpr float U_SCALE = 1024.f, V_SCALE = 256.f;
__device__ __forceinline__ float gelu_tanh(float x) {
    const float u = 0.7978845608028654f * (x + 0.044715f * x * x * x);
    const float e = __expf(2.f * u);
    const float th = 1.f - 2.f / (e + 1.f);
    return 0.5f * x * (1.f + th);
}
struct XcdShare { int xi, nx, wx, nwx; };
__device__ __forceinline__ XcdShare xcd_share(const XcdBarrier& bar, LAS unsigned char* lds, int tid, int wave) {
    volatile LAS unsigned* st = bar.st;
    if (tid == 0) {
        unsigned xi = 0, nx = 0;
#pragma unroll
        for (unsigned j = 0; j < 16; ++j) { const unsigned c = xb_ld(&bar.bar[XB_XCNT(j)]); nx += (c > 0u) ? 1u : 0u; xi += (c > 0u && j < bar.x) ? 1u : 0u; }
        st[3] = xi; st[4] = nx;
    }
    __syncthreads();
#ifdef PROBE_NOAFF
    XcdShare s; s.xi = 0; s.nx = 1; s.wx = blockIdx.x * NWAVES + wave; s.nwx = gridDim.x * NWAVES;
#else
    XcdShare s; s.xi = (int)st[3]; s.nx = (int)st[4]; const int nloc = (int)st[0], rank = (int)st[2];
    s.wx = rank * NWAVES + wave; s.nwx = nloc * NWAVES;
#endif
    return s;
}
struct UnitMap { int xi, nx, wx, nwx, ntok, N; };
__device__ __forceinline__ UnitMap unit_map(const XcdShare& xs) {
    UnitMap m; m.xi = __builtin_amdgcn_readfirstlane(xs.xi); m.nx = __builtin_amdgcn_readfirstlane(xs.nx); m.wx = __builtin_amdgcn_readfirstlane(xs.wx); m.nwx = __builtin_amdgcn_readfirstlane(xs.nwx);
    m.ntok = (xs.wx < T_TOK) ? (T_TOK - 1 - xs.wx) / xs.nwx + 1 : 0;
    const int nsl = (xs.xi < NSLICE) ? (NSLICE - 1 - xs.xi) / xs.nx + 1 : 0;
    m.N = m.ntok * nsl; return m;
}
__device__ __forceinline__ void unit_st(const UnitMap& m, int n, int& s, int& t) { const int si = n / m.ntok, ti = n - si * m.ntok; s = m.xi + si * m.nx; t = m.wx + ti * m.nwx; }
__device__ __forceinline__ u32x4 copy4(const u32x4& s) { u32x4 d; asm volatile("v_mov_b32 %0, %4\n\tv_mov_b32 %1, %5\n\tv_mov_b32 %2, %6\n\tv_mov_b32 %3, %7" : "=&v"(d.x), "=&v"(d.y), "=&v"(d.z), "=&v"(d.w) : "v"(s.x), "v"(s.y), "v"(s.z), "v"(s.w)); return d; }
#define FP8X4_TO_F32(d, f0, f1, f2, f3) do { const f32x2 _lo = __builtin_amdgcn_cvt_pk_f32_fp8((int)(d), false), _hi = __builtin_amdgcn_cvt_pk_f32_fp8((int)(d), true); f0 = _lo[0]; f1 = _lo[1]; f2 = _hi[0]; f3 = _hi[1]; } while (0)

struct PIdx { u32x4 e[4]; };
__device__ __forceinline__ void p_load_idx(const Params& p, const UnitMap& m, int n, int sg, PIdx& I) {
    int s, t; unit_st(m, n < m.N ? n : m.N - 1, s, t);
    const u32x4* ep = (const u32x4*)((const int*)(p.ws + WS_EIDX) + (size_t)t * 128 + 16 * sg);
#pragma unroll
    for (int i = 0; i < 4; ++i) I.e[i] = ep[i];
}
__device__ __forceinline__ void gld16(u32x4& d, unsigned voff, const void* sbase) { asm volatile("global_load_dwordx4 %0, %1, %2" : "=v"(d) : "v"(voff), "s"(sbase) : "memory"); }
__device__ __forceinline__ void gld16nt(u32x4& d, unsigned voff, const void* sbase) { asm volatile("global_load_dwordx4 %0, %1, %2 sc0" : "=v"(d) : "v"(voff), "s"(sbase) : "memory"); }
__device__ __forceinline__ void gld8(u32x2& d, unsigned voff, const void* sbase) { asm volatile("global_load_dwordx2 %0, %1, %2" : "=v"(d) : "v"(voff), "s"(sbase) : "memory"); }
template <int N> __device__ __forceinline__ void vm_wait(u32x4& d) { asm volatile("s_waitcnt vmcnt(%1)" : "+v"(d) : "n"(N) : "memory"); }
template <int N> __device__ __forceinline__ void vm_wait2(u32x2& d) { asm volatile("s_waitcnt vmcnt(%1)" : "+v"(d) : "n"(N) : "memory"); }

__device__ __forceinline__ float u2f(unsigned u) { return __builtin_bit_cast(float, u); }
template <int CTRL> __device__ __forceinline__ int dpp_i(int v) { return __builtin_amdgcn_update_dpp(0, v, CTRL, 0xf, 0xf, false); }
template <int CTRL> __device__ __forceinline__ float dpp_f(float v) { return __builtin_bit_cast(float, __builtin_amdgcn_update_dpp(0, __builtin_bit_cast(int, v), CTRL, 0xf, 0xf, false)); }
__device__ __forceinline__ void peer_u_phase(const Params& p, const XcdShare& xs, int lane) {
    const UnitMap m = unit_map(xs); if (m.N == 0) return;
    const int sg = lane >> 3, pp = lane & 7;
    const bool b0 = (lane & 1) != 0, b1 = (lane & 2) != 0, b2 = (lane & 4) != 0;
    const int pos = 16 * sg + (b2 ? 8 : 0) + (b0 ? 4 : 0) + (b1 ? 2 : 0);
    const unsigned poff = 16u * (unsigned)pp, ioff = 64u * (unsigned)sg, xoff = 32u * (unsigned)pp;
    u32x4 seg[16], x0, x1, nx0, nx1, In[4]; unsigned off[16];
    {
        PIdx I0, I1; p_load_idx(p, m, 0, sg, I0); p_load_idx(p, m, 1, sg, I1);
        int s, t; unit_st(m, 0, s, t);
        const u32x4* xp = (const u32x4*)((const bf16*)(p.ws + WS_XN) + (size_t)t * D_MODEL + 128 * s + 16 * pp); x0 = xp[0]; x1 = xp[1];
        const unsigned char* U = p.ws + WS_U + (size_t)s * N_EXPERTS * 128;
        unsigned o0[16];
#pragma unroll
        for (int i = 0; i < 16; ++i) { o0[i] = I0.e[i >> 2][i & 3] * 128u + poff; off[i] = I1.e[i >> 2][i & 3] * 128u + poff; }
        asm volatile("s_waitcnt vmcnt(0)" ::: "memory");
#pragma unroll
        for (int i = 0; i < 16; ++i) gld16nt(seg[i], o0[i], U);
    }
#pragma unroll 1
    for (int n = 0; n < m.N; ++n) {
        int s, t; unit_st(m, n, s, t);
        int s1, t1; unit_st(m, n + 1 < m.N ? n + 1 : m.N - 1, s1, t1);
        int s2, t2; unit_st(m, n + 2 < m.N ? n + 2 : m.N - 1, s2, t2);
        const unsigned char* U1 = p.ws + WS_U + (size_t)s1 * N_EXPERTS * 128;
        const unsigned char* xb = p.ws + WS_XN + ((size_t)t1 * D_MODEL + 128 * s1) * 2;
        const unsigned char* ib = p.ws + WS_EIDX + (size_t)t2 * 512;
        gld16(nx0, xoff, xb); gld16(nx1, xoff + 16u, xb);
        gld16(In[0], ioff, ib); gld16(In[1], ioff + 16u, ib); gld16(In[2], ioff + 32u, ib); gld16(In[3], ioff + 48u, ib);
        float xf[16];
#pragma unroll
        for (int j = 0; j < 4; ++j) { xf[2 * j] = bf_lo(x0[j]); xf[2 * j + 1] = bf_hi(x0[j]); xf[8 + 2 * j] = bf_lo(x1[j]); xf[8 + 2 * j + 1] = bf_hi(x1[j]); }
        float xm = 0.f;
#pragma unroll
        for (int j = 0; j < 16; j += 2) xm = fmaxf(fmaxf(fabsf(xf[j]), fabsf(xf[j + 1])), xm);
        xm = fmaxf(xm, dpp_f<0x141>(xm)); xm = fmaxf(xm, dpp_f<0xB1>(xm)); xm = fmaxf(xm, dpp_f<0x4E>(xm));
        const float xs = xm > 1e-30f ? (127.f / 32767.f) * __builtin_amdgcn_rcpf(xm) : 0.f, sx = xm * (1.f / 127.f);
        unsigned xq[4];
#pragma unroll
        for (int j = 0; j < 4; ++j) { const auto pa = __builtin_amdgcn_cvt_pknorm_i16(xf[4 * j] * xs, xf[4 * j + 1] * xs), pb = __builtin_amdgcn_cvt_pknorm_i16(xf[4 * j + 2] * xs, xf[4 * j + 3] * xs);
            xq[j] = __builtin_amdgcn_perm(__builtin_bit_cast(unsigned, pb), __builtin_bit_cast(unsigned, pa), 0x06040200u); }
        int a[16];
#pragma unroll
        for (int i = 0; i < 16; ++i) {
            vm_wait<21>(seg[i]);
            int d = 0;
#pragma unroll
            for (int j = 0; j < 4; ++j) d = __builtin_amdgcn_sdot4((int)seg[i][j], (int)xq[j], d, false);
            a[i] = d;
            asm volatile("" : "+v"(a[i]) : "v"(seg[i]) : "memory");
            gld16nt(seg[i], off[i], U1);
        }
        vm_wait<16>(nx0); vm_wait<16>(nx1); vm_wait<16>(In[0]); vm_wait<16>(In[1]); vm_wait<16>(In[2]); vm_wait<16>(In[3]);
        x0 = nx0; x1 = nx1;
#pragma unroll
        for (int i = 0; i < 16; ++i) off[i] = In[i >> 2][i & 3] * 128u + poff;
        int v8[8], v4[4], v2[2];
#pragma unroll
        for (int i = 0; i < 8; ++i) { const int snd = b2 ? a[i] : a[8 + i]; const int kp = b2 ? a[8 + i] : a[i]; v8[i] = kp + dpp_i<0x141>(snd); }
#pragma unroll
        for (int i = 0; i < 4; ++i) { const int snd = b0 ? v8[i] : v8[4 + i]; const int kp = b0 ? v8[4 + i] : v8[i]; v4[i] = kp + dpp_i<0xB1>(snd); }
#pragma unroll
        for (int i = 0; i < 2; ++i) { const int snd = b1 ? v4[i] : v4[2 + i]; const int kp = b1 ? v4[2 + i] : v4[i]; v2[i] = kp + dpp_i<0x4E>(snd); }
        *(unsigned*)((bf16*)(p.ws + WS_APART) + ((size_t)s * T_TOK + t) * 128 + pos) = pk2((float)v2[0] * sx, (float)v2[1] * sx);
    }
    asm volatile("s_waitcnt vmcnt(0)" ::: "memory");
}
__device__ __forceinline__ void peer_reduce(const Params& p, size_t gtid, size_t gthreads) {
    unsigned char* ws = p.ws;
    const bf16* ap = (const bf16*)(ws + WS_APART); const float* gp = (const float*)(ws + WS_EW); float* wo = (float*)(ws + WS_EW2); const float* R = (const float*)(ws + WS_R);
    const unsigned* ei = (const unsigned*)(ws + WS_EIDX); const float* usc = (const float*)(ws + WS_USC);
    for (size_t i = gtid; i < (size_t)T_TOK * 128 / 8; i += gthreads) {
        const float rs = R[i >> 4];
        const u32x4 e0 = *(const u32x4*)(ei + 8 * i), e1 = *(const u32x4*)(ei + 8 * i + 4);
        float us[8];
#pragma unroll
        for (int k = 0; k < 4; ++k) { us[k] = usc[e0[k]] * rs; us[4 + k] = usc[e1[k]] * rs; }
        float a[8];
#pragma unroll
        for (int k = 0; k < 8; ++k) a[k] = 0.f;
#pragma unroll
        for (int s = 0; s < NSLICE; ++s) { const u32x4 v = *(const u32x4*)(ap + (size_t)s * T_TOK * 128 + 8 * i);
            a[0] += bf_lo(v.x); a[1] += bf_hi(v.x); a[2] += bf_lo(v.y); a[3] += bf_hi(v.y); a[4] += bf_lo(v.z); a[5] += bf_hi(v.z); a[6] += bf_lo(v.w); a[7] += bf_hi(v.w); }
        const f32x4 g0 = *(const f32x4*)(gp + 8 * i), g1 = *(const f32x4*)(gp + 8 * i + 4);
        f32x4 o0, o1;
#pragma unroll
        for (int k = 0; k < 4; ++k) { o0[k] = g0[k] * gelu_tanh(a[k] * us[k]) * (1.f / V_SCALE); o1[k] = g1[k] * gelu_tanh(a[4 + k] * us[4 + k]) * (1.f / V_SCALE); }
        *(f32x4*)(wo + 8 * i) = o0; *(f32x4*)(wo + 8 * i + 4) = o1;
    }
}
__device__ __forceinline__ void peer_v_phase(const Params& p, const XcdShare& xs, int lane) {
    const UnitMap m = unit_map(xs); if (m.N == 0) return;
    const int sg = lane >> 3, pp = lane & 7;
    const bool b5 = (lane & 32) != 0, b4 = (lane & 16) != 0, b3 = (lane & 8) != 0;
    const int col = 16 * pp + (b5 ? 8 : 0) + (b4 ? 4 : 0) + (b3 ? 2 : 0);
    const unsigned poff = 16u * (unsigned)pp, ioff = 64u * (unsigned)sg;
    u32x4 seg[16], w[4], nw[4], In[4]; unsigned off[16];
    {
        PIdx I0, I1; p_load_idx(p, m, 0, sg, I0); p_load_idx(p, m, 1, sg, I1);
        int s, t; unit_st(m, 0, s, t);
        const u32x4* wp = (const u32x4*)((const float*)(p.ws + WS_EW2) + (size_t)t * 128 + 16 * sg);
#pragma unroll
        for (int i = 0; i < 4; ++i) w[i] = wp[i];
        const unsigned char* V = p.ws + WS_V + (size_t)s * N_EXPERTS * 128;
        unsigned o0[16];
#pragma unroll
        for (int i = 0; i < 16; ++i) { o0[i] = I0.e[i >> 2][i & 3] * 128u + poff; off[i] = I1.e[i >> 2][i & 3] * 128u + poff; }
        asm volatile("s_waitcnt vmcnt(0)" ::: "memory");
#pragma unroll
        for (int i = 0; i < 16; ++i) gld16nt(seg[i], o0[i], V);
    }
#pragma unroll 1
    for (int n = 0; n < m.N; ++n) {
        int s, t; unit_st(m, n, s, t);
        int s1, t1; unit_st(m, n + 1 < m.N ? n + 1 : m.N - 1, s1, t1);
        int s2, t2; unit_st(m, n + 2 < m.N ? n + 2 : m.N - 1, s2, t2);
        const unsigned char* V1 = p.ws + WS_V + (size_t)s1 * N_EXPERTS * 128;
        const unsigned char* wb = p.ws + WS_EW2 + (size_t)t1 * 512;
        const unsigned char* ib = p.ws + WS_EIDX + (size_t)t2 * 512;
        gld16(nw[0], ioff, wb); gld16(nw[1], ioff + 16u, wb); gld16(nw[2], ioff + 32u, wb); gld16(nw[3], ioff + 48u, wb);
        gld16(In[0], ioff, ib); gld16(In[1], ioff + 16u, ib); gld16(In[2], ioff + 32u, ib); gld16(In[3], ioff + 48u, ib);
        f32x2 ac2[8];
#pragma unroll
        for (int i = 0; i < 8; ++i) ac2[i] = (f32x2){0.f, 0.f};
#pragma unroll
        for (int i = 0; i < 16; ++i) {
            vm_wait<23>(seg[i]);
            const float wi = u2f(w[i >> 2][i & 3]); const f32x2 wi2 = {wi, wi};
#pragma unroll
            for (int j = 0; j < 4; ++j) { const unsigned dw = seg[i][j]; const f32x2 lo = __builtin_amdgcn_cvt_pk_f32_fp8((int)dw, false), hi = __builtin_amdgcn_cvt_pk_f32_fp8((int)dw, true);
                ac2[2 * j] = __builtin_elementwise_fma(lo, wi2, ac2[2 * j]); ac2[2 * j + 1] = __builtin_elementwise_fma(hi, wi2, ac2[2 * j + 1]); }
            asm volatile("" : "+v"(ac2[0]), "+v"(ac2[1]), "+v"(ac2[2]), "+v"(ac2[3]) : "v"(seg[i]) : "memory");
            asm volatile("" : "+v"(ac2[4]), "+v"(ac2[5]), "+v"(ac2[6]), "+v"(ac2[7]) : "v"(seg[i]) : "memory");
            gld16nt(seg[i], off[i], V1);
        }
        float acc[16];
#pragma unroll
        for (int i = 0; i < 8; ++i) { acc[2 * i] = ac2[i][0]; acc[2 * i + 1] = ac2[i][1]; }
        float v8[8], v4[4], v2[2];
#pragma unroll
        for (int i = 0; i < 8; ++i) { const auto s = __builtin_amdgcn_permlane32_swap(__builtin_bit_cast(unsigned, acc[i]), __builtin_bit_cast(unsigned, acc[8 + i]), false, false); const unsigned s0 = s[0], s1 = s[1]; v8[i] = u2f(s0) + u2f(s1); }
#pragma unroll
        for (int i = 0; i < 4; ++i) { const auto s = __builtin_amdgcn_permlane16_swap(__builtin_bit_cast(unsigned, v8[i]), __builtin_bit_cast(unsigned, v8[4 + i]), false, false); const unsigned s0 = s[0], s1 = s[1]; v4[i] = u2f(s0) + u2f(s1); }
#pragma unroll
        for (int i = 0; i < 2; ++i) { const float snd = b3 ? v4[i] : v4[2 + i]; const float kp = b3 ? v4[2 + i] : v4[i]; v2[i] = kp + dpp_f<0x128>(snd); }
        *(unsigned*)((bf16*)(p.ws + WS_PD) + (size_t)t * D_MODEL + 128 * s + col) = pk2(v2[0], v2[1]);
        vm_wait<16>(nw[0]); vm_wait<16>(nw[1]); vm_wait<16>(nw[2]); vm_wait<16>(nw[3]); vm_wait<16>(In[0]); vm_wait<16>(In[1]); vm_wait<16>(In[2]); vm_wait<16>(In[3]);
#pragma unroll
        for (int i = 0; i < 4; ++i) w[i] = nw[i];
#pragma unroll
        for (int i = 0; i < 16; ++i) off[i] = In[i >> 2][i & 3] * 128u + poff;
    }
    asm volatile("s_waitcnt vmcnt(0)" ::: "memory");
}
__global__ void __launch_bounds__(NTHREADS, 2) fwd_megakernel(Params p) {
    extern __shared__ __attribute__((aligned(16))) unsigned char lds_raw[];
    LAS unsigned char* lds = (LAS unsigned char*)lds_raw;
    const int tid = threadIdx.x, lane = tid & 63, wave = __builtin_amdgcn_readfirstlane(tid >> 6);
    unsigned char* ws = p.ws;
    const int G = gridDim.x;
    const int gw = blockIdx.x * NWAVES + wave, NGW = G * NWAVES;
    const int lo = p.ph_lo, hi = p.ph_hi;
#ifndef PROBE_DOUBLE
#define PROBE_DOUBLE -1
#endif
#define IN(k) (lo <= (k) && (k) < hi)
#define REP(k) for (int _rep = 0; _rep < (((k) == PROBE_DOUBLE && (k) != 1 && (k) != 4 && (k) != 6) ? 2 : 1); ++_rep)
#define GREP(k) ((k) == PROBE_DOUBLE ? 2 : 1)
#define SEAM(k) do { if (IN(k) && IN((k) + 1)) xcd_barrier(bar); } while (0)
#define SEAM_FILL(k, k2, f) do { if (IN(k) && IN(k2)) { const unsigned _tg = xcd_barrier_arrive(bar); \
        convert_i8_rows(p.in[I_PU], ws + WS_U, (float*)(ws + WS_USC), gw, NGW, lane, p.in[I_FNW], U_ROWS_P0 + (f) * U_ROWS_FILL, U_ROWS_P0 + ((f) + 1) * U_ROWS_FILL); \
        xcd_barrier_wait(bar, _tg); } } while (0)

    if (tid < 16) ((volatile LAS unsigned*)(lds + LDS_CTL_OFF))[tid] = 0u;
    __syncthreads();
    XcdBarrier bar = xcd_barrier_post((unsigned*)(ws + WS_CTL), (volatile LAS unsigned*)(lds + LDS_CTL_OFF));
#ifdef PROBE_SYNCS
    for (int _i = 0; _i < PROBE_SYNCS; ++_i) xcd_barrier(bar);
#endif
    if (IN(0)) REP(0) { phase_prologue(p, lds, tid, lane, wave); __syncthreads(); }
    SEAM_FILL(0, 1, 0);
    if (IN(1)) REP(1) {
        pg8::Gemm g{(const bf16*)(ws + WS_XN), (const bf16*)(ws + WS_WIN_T), T_TOK, N_IN_PAD, D_MODEL};
        pg8::StaticOrder S; S.init(T_TOK, N_IN_PAD, G, (int)blockIdx.x, GREP(1));
        EpiInProj E{ws, 0.08838834764831845f * 1.4426950408889634f};
        pg8::gemm_phase<EpiInProj, pg8::StaticOrder>(lds, g, S, E);
    }
    SEAM_FILL(1, 2, 1);
    if (IN(2)) REP(2) {
        if (G >= 256) {
            if (blockIdx.x < 128) compress_unit(p, lds, blockIdx.x, tid, lane, wave);
            else convert_fp8_sliced(p.in[I_PV], ws + WS_V, 256.f, (blockIdx.x - 128) * NWAVES + wave, (G - 128) * NWAVES, lane, nullptr, V_HALF_P0, N_EXPERTS * 2);
        } else {
            for (int m = gw; m < T_TOK; m += NGW) conv_token(p, m, lane);
            for (int u = blockIdx.x; u < 128; u += G) compress_unit(p, lds, u, tid, lane, wave);
            convert_fp8_sliced(p.in[I_PV], ws + WS_V, 256.f, gw, NGW, lane, nullptr, V_HALF_P0, N_EXPERTS * 2);
        }
    }
    SEAM_FILL(2, 3, 2);
    if (IN(3)) REP(3) {
        for (int k = 0; ; ++k) {
            const int base = (k >> 1) * 2 * G; if (base >= 512) break;
            const int idx = (k & 1) ? base + 2 * G - 1 - (int)blockIdx.x : base + (int)blockIdx.x;
            if (idx >= 512) continue;
            attn_unit(p, lds, idx, tid, lane, wave);
        }
        if (G >= 256) { for (int m = gw; m < T_TOK; m += NGW) conv_token(p, m, lane); }
    }
    SEAM_FILL(3, 4, 3);
    if (IN(4)) REP(4) {
        pg8::Gemm g{(const bf16*)(ws + WS_MIXED), (const bf16*)(ws + WS_WOUT_T), T_TOK, D_MODEL, D_MODEL};
        pg8::StaticOrder S; S.init(T_TOK, D_MODEL, G, (int)blockIdx.x, GREP(4));
        EpiResF32H E{p.in[I_X], (float*)(ws + WS_H), (bf16*)(ws + WS_XN), (float*)(ws + WS_SSP)};
        pg8::gemm_phase<EpiResF32H, pg8::StaticOrder>(lds, g, S, E);
    }
    SEAM_FILL(4, 6, 4);
    if (IN(6)) REP(6) {
        pg8::Gemm g{(const bf16*)(ws + WS_XN), (const bf16*)(ws + WS_WQ_T), T_TOK, D_MODEL, D_MODEL};
        pg8::StaticOrder S; S.init(T_TOK, D_MODEL, G, (int)blockIdx.x, GREP(6));
        EpiBf16Row E{(bf16*)(ws + WS_PQ), D_MODEL, (const float*)(ws + WS_SSP), (float*)(ws + WS_R)};
        pg8::gemm_phase<EpiBf16Row, pg8::StaticOrder>(lds, g, S, E);
    }
    SEAM_FILL(6, 7, 5);
    if (IN(7)) REP(7) {
        for (int u = blockIdx.x; u < T_TOK / 32; u += G) peer_topk_pass(p, lds, u, tid, lane, wave);
    }
    SEAM(7);
    if (IN(8)) REP(8) {
        const XcdShare xs = xcd_share(bar, lds, tid, wave);
        peer_u_phase(p, xs, lane);
    }
    SEAM(8);
    if (IN(9)) REP(9) {
        peer_reduce(p, (size_t)blockIdx.x * NTHREADS + tid, (size_t)G * NTHREADS);
    }
    SEAM(9);
    if (IN(10)) REP(10) {
        const XcdShare xs = xcd_share(bar, lds, tid, wave);
        peer_v_phase(p, xs, lane);
    }
    SEAM(10);
    if (IN(11)) REP(11) {
        for (int m = gw; m < T_TOK; m += NGW) rms_row_add_to_f32((const bf16*)(ws + WS_XN) + (size_t)m * D_MODEL, (const bf16*)(ws + WS_PD) + (size_t)m * D_MODEL, p.in[I_FINW], p.out + (size_t)m * D_MODEL, lane);
    }
#undef IN
#undef SEAM
}

extern "C" void kernel_launch(void* const* d_in, const int* in_sizes, int n_in, void* d_out, int out_size, void* d_ws, size_t ws_size, hipStream_t stream) {
    static int grid_blocks = 0;
    if (grid_blocks == 0) {
        if (n_in != 18 || ws_size < WS_END) { fprintf(stderr, "kernel_launch: unexpected n_in %d / ws_size %zu\n", n_in, ws_size); grid_blocks = -1; return; }
        int dev = 0, cus = 0, per_cu = 0;
        (void)hipGetDevice(&dev);
        (void)hipDeviceGetAttribute(&cus, hipDeviceAttributeMultiprocessorCount, dev);
        (void)hipFuncSetAttribute((const void*)fwd_megakernel, hipFuncAttributeMaxDynamicSharedMemorySize, LDS_BYTES);
        (void)hipOccupancyMaxActiveBlocksPerMultiprocessor(&per_cu, (const void*)fwd_megakernel, NTHREADS, LDS_BYTES);
        if (per_cu < 1) { fprintf(stderr, "kernel_launch: occupancy query says %d blocks/CU\n", per_cu); per_cu = 1; }
        if (per_cu > 1) per_cu = 1;
        grid_blocks = cus * per_cu;
        fprintf(stderr, "kernel_launch: grid %d (cus %d)\n", grid_blocks, cus);
    }
    if (grid_blocks < 0) return;
    (void)hipMemsetAsync((char*)d_ws + WS_CTL, 0, CTL_BYTES, stream);
    Params p{};
    for (int i = 0; i < 18; ++i) p.in[i] = (const float*)d_in[i];
    p.out = (float*)d_out; p.ws = (unsigned char*)d_ws; p.ph_lo = 0; p.ph_hi = 16;
    void* args[] = {&p};
    hipError_t e = hipLaunchCooperativeKernel((const void*)fwd_megakernel, dim3(grid_blocks), dim3(NTHREADS), args, LDS_BYTES, stream);
    if (e != hipSuccess) fprintf(stderr, "cooperative launch failed: %s (grid %d)\n", hipGetErrorString(e), grid_blocks);
}
```

```cpp
#include <hip/hip_runtime.h>
#include <hip/hip_cooperative_groups.h>
#include <cstdio>
namespace cg = cooperative_groups;

#define LAS __attribute__((address_space(3)))
typedef unsigned short bf16;
typedef short bf16x8 __attribute__((ext_vector_type(8)));
typedef float f32x4 __attribute__((ext_vector_type(4)));
typedef float f32x2 __attribute__((ext_vector_type(2)));
typedef unsigned u32x4 __attribute__((ext_vector_type(4)));
typedef unsigned u32x2 __attribute__((ext_vector_type(2)));

constexpr int D_MODEL = 2048, BATCH = 2, SEQ = 4096, T_TOK = BATCH * SEQ;
constexpr int D_ATTN = 1024, D_CONV = 1024, HEAD_DIM = 128, N_KV = 2, GQA = 4;
constexpr int N_IN_PAD = 5888, N_IN = 5656;
constexpr int N_CMP = 255;
constexpr int N_EXPERTS = 16384;
constexpr float EPS = 1e-6f;
constexpr int NTHREADS = 512, NWAVES = 8;
constexpr int LDS_BYTES = 147456;
constexpr int LDS_CTL_OFF = LDS_BYTES - 64;
constexpr int U_ROWS_P0 = 2048, U_ROWS_FILL = 2048, U_NFILL = 6;
constexpr int U_ROWS_P2 = 2048;
static_assert(U_ROWS_P0 + U_NFILL * U_ROWS_FILL + U_ROWS_P2 == N_EXPERTS, "U conversion split");
constexpr int V_ROWS_LATE = 2048;
constexpr int U_HALF_P0 = 32768;
constexpr int V_HALF_P0 = 0;

constexpr size_t MiB = 1u << 20;
constexpr size_t WS_WIN_T = 0;
constexpr size_t WS_WOUT_T = 24 * MiB;
constexpr size_t WS_WQ_T = 32 * MiB;
constexpr size_t WS_XN = 40 * MiB;
constexpr size_t WS_Q = 72 * MiB;
constexpr size_t WS_KC = 88 * MiB;
constexpr size_t WS_VC = 92 * MiB;
constexpr size_t WS_KS = 96 * MiB;
constexpr size_t WS_VST = 100 * MiB;
constexpr size_t WS_KW = 104 * MiB;
constexpr size_t WS_VWT = 108 * MiB;
constexpr size_t WS_BG = 112 * MiB;
constexpr size_t WS_CG = 128 * MiB;
constexpr size_t WS_HC = 144 * MiB;
constexpr size_t WS_GL = 160 * MiB;
constexpr size_t WS_MIXED = 162 * MiB;
constexpr size_t WS_APART = 72 * MiB;
constexpr size_t WS_H = 200 * MiB;
constexpr size_t WS_USC = 200 * MiB;
constexpr size_t WS_VSC = 200 * MiB + 65536;
constexpr size_t WS_WSC = 200 * MiB + 131072;
constexpr size_t WS_RX = 200 * MiB + 196608;
constexpr size_t WS_PQ = 264 * MiB;
constexpr size_t WS_U = 296 * MiB;
constexpr size_t WS_V = 360 * MiB;
constexpr size_t WS_WCK_T = 424 * MiB;
constexpr size_t WS_WCV_T = 425 * MiB;
constexpr size_t WS_SK = 426 * MiB;
constexpr size_t WS_KCMP = 427 * MiB;
constexpr size_t WS_VCMPT = 428 * MiB;
constexpr size_t WS_CCONST = 429 * MiB;
constexpr size_t WS_EIDX = 430 * MiB;
constexpr size_t WS_EW = 434 * MiB;
constexpr size_t WS_EW2 = 438 * MiB;
constexpr size_t WS_CTL = 442 * MiB;
constexpr size_t CTL_BYTES = 65536;
constexpr size_t WS_SSP = 443 * MiB;
constexpr size_t WS_R = 444 * MiB;
constexpr size_t WS_PD = 445 * MiB;
constexpr size_t WS_END = 477 * MiB;
static_assert(WS_APART + (size_t)16 * 8192 * 128 * 4 <= WS_H, "APART overlay");

struct Params {
    const float* in[18];
    float* out;
    unsigned char* ws;
    int ph_lo, ph_hi;
};
enum { I_X = 0, I_ANW, I_WIN, I_WCK, I_WCV, I_CPOS, I_CW, I_CB, I_AGNW, I_CGNW, I_WOUT, I_RB, I_FNW, I_PWQ, I_PSK, I_PU, I_PV, I_FINW };

__device__ __forceinline__ unsigned f2bf(float f) { unsigned u = __builtin_bit_cast(unsigned, f); return (u + 0x7fffu + ((u >> 16) & 1u)) >> 16; }
__device__ __forceinline__ unsigned pk2(float lo, float hi) { unsigned r; asm("v_cvt_pk_bf16_f32 %0, %1, %2" : "=v"(r) : "v"(lo), "v"(hi)); return r; }
__device__ __forceinline__ float bf_lo(unsigned w) { return __builtin_bit_cast(float, w << 16); }
__device__ __forceinline__ float bf_hi(unsigned w) { return __builtin_bit_cast(float, w & 0xffff0000u); }
__device__ __forceinline__ float wave_sum(float v) {
#pragma unroll
    for (int o = 1; o < 64; o <<= 1) v += __shfl_xor(v, o);
    return v;
}
#define LDS_WAIT() asm volatile("s_waitcnt lgkmcnt(0)" ::: "memory")

#define XB_TMO      128
#define XB_XCNT(j)  (256  + 64 * (j))
#define XB_XSUB(j)  (1280 + 64 * (j))
#define XB_XGEN(j)  (2304 + 64 * (j))
#define XB_TOP      3328
#define XB_TOPGEN   3392
#define XCD_BAR_WORDS 3456
#define XB_SPIN_CAP (1u << 20)
__device__ __forceinline__ unsigned xb_ld(unsigned* p)              { return __hip_atomic_load(p, __ATOMIC_RELAXED, __HIP_MEMORY_SCOPE_AGENT); }
__device__ __forceinline__ unsigned xb_add(unsigned* p, unsigned v) { return __hip_atomic_fetch_add(p, v, __ATOMIC_RELAXED, __HIP_MEMORY_SCOPE_AGENT); }
__device__ __forceinline__ unsigned xb_xcc_id() { return (unsigned)__builtin_amdgcn_s_getreg((3 << 11) | 20) & 0xFu; }
#define XB_SPIN(cond, bar) do { unsigned _sp = 0; while (cond) { __builtin_amdgcn_s_sleep(1); \
    if ((++_sp & 255u) == 0u) { if (xb_ld(&(bar)[XB_TMO])) break; if (_sp > XB_SPIN_CAP) { atomicAdd(&(bar)[XB_TMO], 1u); break; } } } } while (0)
struct XcdBarrier { unsigned* bar; unsigned x; unsigned rank; volatile LAS unsigned* st; };
__device__ __forceinline__ XcdBarrier xcd_barrier_post(unsigned* bar, volatile LAS unsigned* st) {
    XcdBarrier b; b.bar = bar; b.x = xb_xcc_id(); b.st = st; b.rank = 0;
    if (threadIdx.x == 0) st[2] = xb_add(&bar[XB_XCNT(b.x)], 1u);
    return b;
}
__device__ __forceinline__ void xcd_barrier_complete(unsigned* bar, unsigned x, unsigned& nloc, unsigned& nx) {
    const unsigned G = gridDim.x * gridDim.y * gridDim.z;
    unsigned sum, cnt, mine, sp = 0u;
    for (;;) {
        sum = 0u; cnt = 0u; mine = 0u;
#pragma unroll
        for (unsigned j = 0; j < 16; ++j) { const unsigned c = xb_ld(&bar[XB_XCNT(j)]); sum += c; cnt += (c > 0u) ? 1u : 0u; mine = (j == x) ? c : mine; }
        if (sum == G) break;
        __builtin_amdgcn_s_sleep(1);
        if ((++sp & 255u) == 0u) { if (xb_ld(&bar[XB_TMO])) break; if (sp > XB_SPIN_CAP) { atomicAdd(&bar[XB_TMO], 1u); break; } }
    }
    nloc = mine > 0u ? mine : 1u; nx = cnt > 0u ? cnt : 1u;
}
__device__ __forceinline__ unsigned xcd_barrier_arrive(const XcdBarrier& b) {
    unsigned target = 0u;
    asm volatile("s_waitcnt vmcnt(0)" ::: "memory");
    __syncthreads();
    if (threadIdx.x == 0) {
        unsigned* bar = b.bar;
        __builtin_amdgcn_s_waitcnt(0);
        unsigned nloc = b.st[0], nx = b.st[1];
        if (nloc == 0u) { xcd_barrier_complete(bar, b.x, nloc, nx); b.st[0] = nloc; b.st[1] = nx; }
        const unsigned old = xb_add(&bar[XB_XSUB(b.x)], 1u);
        const unsigned gen = old / nloc; target = (gen + 1u) * nx;
        if (old + 1u == (gen + 1u) * nloc) {
            __builtin_amdgcn_fence(__ATOMIC_RELEASE, "agent");
            asm volatile("s_waitcnt vmcnt(0)" ::: "memory");
            (void)xb_add(&bar[XB_TOP], 1u);
        }
    }
    return target;
}
__device__ __forceinline__ void xcd_barrier_wait(const XcdBarrier& b, unsigned target) {
    if (threadIdx.x == 0) {
        unsigned* bar = b.bar;
        XB_SPIN(xb_ld(&bar[XB_TOP]) < target, bar);
        __builtin_amdgcn_fence(__ATOMIC_ACQUIRE, "agent");
        asm volatile("s_waitcnt vmcnt(0)" ::: "memory");
    }
    __syncthreads();
}
__device__ __forceinline__ void xcd_barrier(const XcdBarrier& b) {
    asm volatile("s_waitcnt vmcnt(0)" ::: "memory");
    __syncthreads();
    if (threadIdx.x == 0) {
        unsigned* bar = b.bar;
        __builtin_amdgcn_s_waitcnt(0);
        unsigned nloc = b.st[0], nx = b.st[1];
        if (nloc == 0u) { xcd_barrier_complete(bar, b.x, nloc, nx); b.st[0] = nloc; b.st[1] = nx; }
        const unsigned old = xb_add(&bar[XB_XSUB(b.x)], 1u);
        const unsigned gen = old / nloc, target = (gen + 1u) * nx;
        if (old + 1u == (gen + 1u) * nloc) {
            __builtin_amdgcn_fence(__ATOMIC_RELEASE, "agent");
            asm volatile("s_waitcnt vmcnt(0)" ::: "memory");
            (void)xb_add(&bar[XB_TOP], 1u);
        }
        XB_SPIN(xb_ld(&bar[XB_TOP]) < target, bar);
        __builtin_amdgcn_fence(__ATOMIC_ACQUIRE, "agent");
        asm volatile("s_waitcnt vmcnt(0)" ::: "memory");
    }
    __syncthreads();
}

namespace pg8 {
#define PG8_LAS __attribute__((address_space(3)))
typedef unsigned short bf16_t;
typedef short bf16x8 __attribute__((ext_vector_type(8)));
typedef float f32x4 __attribute__((ext_vector_type(4)));
typedef unsigned u32x4 __attribute__((ext_vector_type(4)));
constexpr int BM = 256, BK = 64, HALF = 128, HTB = HALF * BK * 2  , STAGE_BYTES = 8 * HTB, NXCD = 8, WGM = 8;

__host__ __device__ __forceinline__ int lds_byte(int r, int c) { const int st = (r >> 4) * 2 + (c >> 5), rr = r & 15, cc = c & 31, ob = rr * 64 + cc * 2; return st * 1024 + (ob ^ (((ob >> 9) & 1) << 5)); }
__host__ __device__ __forceinline__ void stage_rc(int b, int& R, int& C) { const int st = b / 1024, sb = b % 1024, swz = sb ^ (((sb >> 9) & 1) << 5); R = (st >> 1) * 16 + swz / 64; C = (st & 1) * 32 + (swz % 64) / 2; }
__host__ __device__ __forceinline__ int perm32(int rho) { const int n = rho >> 4, i = rho & 15; return 8 * (i >> 2) + 4 * n + (i & 3); }

struct Unit { int pm, pn; };
struct Gemm { const bf16_t* A; const bf16_t* Bt; int M, N, K; };

struct StaticOrder {
    int nM, nN, nwg, G, c, rep;
    __host__ __device__ void init(int M, int N, int G_, int c_, int rep_ = 1) { nM = M / BM; nN = N / BM; nwg = nM * nN; G = G_; c = c_; rep = rep_; }
    __host__ __device__ bool next(int i, Unit& u) const {
        const long L = (long)i * G + c; if (L >= (long)nwg * rep) return false;
        int wgid = (int)(L % nwg); { const int q = nwg / NXCD, r = nwg % NXCD, xcd = wgid % NXCD, off = wgid / NXCD; wgid = (xcd < r ? xcd * (q + 1) : r * (q + 1) + (xcd - r) * q) + off; }
        const int nig = WGM * nN, gid = wgid / nig, fm = gid * WGM, gsz = (nM - fm) < WGM ? (nM - fm) : WGM;
        u.pm = fm + ((wgid % nig) % gsz); u.pn = (wgid % nig) / gsz; return true;
    }
    __device__ __forceinline__ void a_ready(const Unit&) const {}
    __device__ __forceinline__ void done(const Unit&) const {}
};

template <class Epi, class Sched>
__device__ __forceinline__ void gemm_phase(PG8_LAS unsigned char* lds, const Gemm g, const Sched& S, const Epi& E) {
    const int tid = threadIdx.x, wid = __builtin_amdgcn_readfirstlane(tid >> 6), lane = tid & 63, wr = wid >> 2, wc = wid & 3, fr = lane & 15, fq = lane >> 4;
    const int K = g.K, nt = K / BK;
    unsigned voffA[2], voffB[2];
#pragma unroll
    for (int i = 0; i < 2; ++i) { int R, C; stage_rc(tid * 16 + i * 8192, R, C); const int Rb = Epi::PERM ? ((R & ~31) + perm32(R & 31)) : R;
        voffA[i] = (unsigned)(R * K + C) * 2u; voffB[i] = (unsigned)(Rb * K + C) * 2u; }
    const size_t kstep = (size_t)(BK * 2);
    const size_t hstep = (size_t)HALF * K * 2;
    const size_t tstep = 2 * hstep;
    const unsigned ldsw = (unsigned)wid * 1024u;
    const int aoff = lds_byte(wr * 64 + fr, fq * 8), boff = lds_byte(wc * 32 + fr, fq * 8);
#define PG8_SA(b, h) (((b) * 2 + (h)) * HTB)
#define PG8_SB(b, h) ((4 + (b) * 2 + (h)) * HTB)
#define PG8_STAGE(bufoff, gbase, voff) do { _Pragma("unroll") for (int _i = 0; _i < 2; ++_i) \
        __builtin_amdgcn_global_load_lds((const unsigned*)((const char*)(gbase) + (voff)[_i]), (PG8_LAS unsigned*)(lds + (bufoff) + ldsw + _i * 8192), 16, 0, 0); } while (0)
#define PG8_LDA(dst, b, h) do { _Pragma("unroll") for (int m = 0; m < 4; ++m) _Pragma("unroll") for (int k = 0; k < 2; ++k) dst[m][k] = *(const PG8_LAS bf16x8*)(lds + PG8_SA(b, h) + aoff + m * 2048 + k * 1024); } while (0)
#define PG8_LDB(dst, b, h) do { _Pragma("unroll") for (int n = 0; n < 2; ++n) _Pragma("unroll") for (int k = 0; k < 2; ++k) dst[n][k] = *(const PG8_LAS bf16x8*)(lds + PG8_SB(b, h) + boff + n * 2048 + k * 1024); } while (0)
#define PG8_MMA(ai, bj, At, Bt) do { __builtin_amdgcn_s_setprio(1); _Pragma("unroll") for (int m = 0; m < 4; ++m) _Pragma("unroll") for (int n = 0; n < 2; ++n) _Pragma("unroll") for (int k = 0; k < 2; ++k) \
        acc[ai][bj][m][n] = __builtin_amdgcn_mfma_f32_16x16x32_bf16(Bt[n][k], At[m][k], acc[ai][bj][m][n], 0, 0, 0); __builtin_amdgcn_s_setprio(0); } while (0)
#define PG8_WAIT_V(n) asm volatile("s_waitcnt vmcnt(" #n ")" ::: "memory")
#define PG8_WAIT_L(n) asm volatile("s_waitcnt lgkmcnt(" #n ")" ::: "memory")
#define PG8_BAR __builtin_amdgcn_s_barrier()
#define PG8_SCHED __builtin_amdgcn_sched_barrier(0)
    Unit cur, nxt; int ui = 0;
    if (!S.next(0, cur)) return;
    f32x4 acc[2][2][4][2];
#pragma unroll
    for (int a = 0; a < 2; ++a)
#pragma unroll
        for (int b = 0; b < 2; ++b)
#pragma unroll
            for (int m = 0; m < 4; ++m)
#pragma unroll
                for (int n = 0; n < 2; ++n) acc[a][b][m][n] = (f32x4){0.f, 0.f, 0.f, 0.f};
    bf16x8 At[4][2], B0[2][2], B1[2][2];
    const char* cA = (const char*)g.A + (size_t)cur.pm * tstep; const char* cB = (const char*)g.Bt + (size_t)cur.pn * tstep;
    S.a_ready(cur);
    PG8_STAGE(PG8_SB(0, 0), cB, voffB); PG8_STAGE(PG8_SA(0, 0), cA, voffA); PG8_STAGE(PG8_SB(0, 1), cB + hstep, voffB); PG8_STAGE(PG8_SA(0, 1), cA + hstep, voffA);
    if (wr == 1) PG8_BAR;
    PG8_WAIT_V(4); PG8_BAR;
    PG8_STAGE(PG8_SB(1, 0), cB + kstep, voffB); PG8_STAGE(PG8_SA(1, 0), cA + kstep, voffA); PG8_STAGE(PG8_SB(1, 1), cB + hstep + kstep, voffB);
    PG8_WAIT_V(6); PG8_BAR;
    for (;;) {
        const bool has_next = S.next(ui + 1, nxt);
        const char* nA = has_next ? (const char*)g.A + (size_t)nxt.pm * tstep : cA; const char* nB = has_next ? (const char*)g.Bt + (size_t)nxt.pn * tstep : cB;
        for (int t = 0; t < nt; t += 2) {
            const bool last = (t == nt - 2);
            const char* a1 = cA + (size_t)(t + 1) * kstep;
            const char* a2 = last ? nA : cA + (size_t)(t + 2) * kstep; const char* b2 = last ? nB : cB + (size_t)(t + 2) * kstep;
            const char* a3 = a2 + kstep; const char* b3 = b2 + kstep;
            if (last && has_next) S.a_ready(nxt);
            PG8_LDB(B0, 0, 0); PG8_SCHED; PG8_LDA(At, 0, 0); PG8_STAGE(PG8_SA(1, 1), a1 + hstep, voffA);
            PG8_WAIT_L(8); PG8_BAR; PG8_WAIT_L(0); PG8_MMA(0, 0, At, B0); PG8_BAR; PG8_SCHED;
            PG8_LDB(B1, 0, 1); PG8_STAGE(PG8_SB(0, 0), b2, voffB);
            PG8_BAR; PG8_WAIT_L(0); PG8_MMA(0, 1, At, B1); PG8_BAR;
            PG8_LDA(At, 0, 1); PG8_STAGE(PG8_SA(0, 0), a2, voffA);
            PG8_BAR; PG8_WAIT_L(0); PG8_MMA(1, 0, At, B0); PG8_BAR; PG8_SCHED;
            PG8_STAGE(PG8_SB(0, 1), b2 + hstep, voffB);
            PG8_WAIT_V(6); PG8_BAR; PG8_MMA(1, 1, At, B1); PG8_BAR;
            PG8_LDB(B0, 1, 0); PG8_SCHED; PG8_LDA(At, 1, 0); PG8_STAGE(PG8_SA(0, 1), a2 + hstep, voffA);
            PG8_WAIT_L(8); PG8_BAR; PG8_WAIT_L(0); PG8_MMA(0, 0, At, B0); PG8_BAR; PG8_SCHED;
            PG8_LDB(B1, 1, 1); PG8_STAGE(PG8_SB(1, 0), b3, voffB);
            PG8_BAR; PG8_WAIT_L(0); PG8_MMA(0, 1, At, B1); PG8_BAR;
            PG8_LDA(At, 1, 1); PG8_STAGE(PG8_SA(1, 0), a3, voffA);
            PG8_BAR; PG8_WAIT_L(0); PG8_MMA(1, 0, At, B0); PG8_BAR; PG8_SCHED;
            PG8_STAGE(PG8_SB(1, 1), b3 + hstep, voffB);
            PG8_WAIT_V(6); PG8_BAR; PG8_MMA(1, 1, At, B1); PG8_BAR;
        }
        if constexpr (!Epi::AFTER_DRAIN) { E(acc, cur, wr, wc, fr, fq); S.done(cur); }
        if (!has_next) break;
#pragma unroll
        for (int a = 0; a < 2; ++a)
#pragma unroll
            for (int b = 0; b < 2; ++b)
#pragma unroll
                for (int m = 0; m < 4; ++m)
#pragma unroll
                    for (int n = 0; n < 2; ++n) acc[a][b][m][n] = (f32x4){0.f, 0.f, 0.f, 0.f};
        cur = nxt; cA = nA; cB = nB; ++ui;
    }
    PG8_WAIT_V(0);
    if (wr == 0) PG8_BAR;
    PG8_BAR;
    if constexpr (Epi::AFTER_DRAIN) { E.fused(acc, cur, wr, wc, fr, fq, lds, wid, lane); S.done(cur); }
#undef PG8_SA
#undef PG8_SB
#undef PG8_STAGE
#undef PG8_LDA
#undef PG8_LDB
#undef PG8_MMA
#undef PG8_WAIT_V
#undef PG8_WAIT_L
#undef PG8_BAR
#undef PG8_SCHED
}
}
struct EpiInProj {
    static constexpr bool PERM = true, AFTER_DRAIN = false;
    unsigned char* ws; float qscale;
    __device__ __forceinline__ void operator()(const pg8::f32x4 (&acc0)[2][2][4][2], const pg8::Unit& u, int wr, int wc, int fr, int fq) const {
        const int pn = u.pn;
        const int row0 = u.pm * 256 + wr * 64 + fr;
        const pg8::f32x4 (&acc)[2][2][4][2] = acc0;
        if (pn == 22) {
            if (wc == 0) {
                float* GL = (float*)(ws + WS_GL);
#pragma unroll
                for (int ai = 0; ai < 2; ++ai)
#pragma unroll
                    for (int m = 0; m < 4; ++m) { float* p = GL + (size_t)(row0 + ai * 128 + m * 16) * 32 + 8 * fq;
                        *(f32x4*)p = acc[ai][0][m][0]; *(f32x4*)(p + 4) = acc[ai][0][m][1]; }
            }
            return;
        }
        if (pn == 7 || pn == 9) {
            bf16* VT = (bf16*)(ws + (pn == 7 ? WS_VST : WS_VWT));
#pragma unroll
            for (int ai = 0; ai < 2; ++ai)
#pragma unroll
                for (int m = 0; m < 4; ++m) { const int row = row0 + ai * 128 + m * 16, b = row >> 12, s = row & 4095;
#pragma unroll
                    for (int bj = 0; bj < 2; ++bj) { bf16* p = VT + ((size_t)((b * 2 + bj) * 128 + wc * 32 + 8 * fq)) * SEQ + s;
#pragma unroll
                        for (int n = 0; n < 2; ++n)
#pragma unroll
                            for (int j = 0; j < 4; ++j) p[(size_t)(4 * n + j) * SEQ] = (bf16)f2bf(acc[ai][bj][m][n][j]); } }
            return;
        }
        if (pn >= 4 && pn <= 9) {
            bf16* KB = (bf16*)(ws + WS_KC + (size_t)(pn - 4) * 4 * MiB);
#pragma unroll
            for (int ai = 0; ai < 2; ++ai)
#pragma unroll
                for (int m = 0; m < 4; ++m) { const int row = row0 + ai * 128 + m * 16, b = row >> 12, s = row & 4095;
#pragma unroll
                    for (int bj = 0; bj < 2; ++bj) { bf16* p = KB + ((size_t)((b * 2 + bj) * SEQ + s)) * 128 + wc * 32 + 8 * fq;
                        const f32x4 v0 = acc[ai][bj][m][0], v1 = acc[ai][bj][m][1];
                        u32x4 w; w.x = pk2(v0[0], v0[1]); w.y = pk2(v0[2], v0[3]); w.z = pk2(v1[0], v1[1]); w.w = pk2(v1[2], v1[3]);
                        *(u32x4*)p = w; } }
            return;
        }
        bf16* O; int colt; float sc = 1.f;
        if (pn < 4) { O = (bf16*)(ws + WS_Q); colt = pn * 256; sc = qscale; }
        else { const int k = (pn - 10) >> 2; O = (bf16*)(ws + WS_BG + (size_t)k * 16 * MiB); colt = ((pn - 10) & 3) * 256; }
#pragma unroll
        for (int ai = 0; ai < 2; ++ai)
#pragma unroll
            for (int m = 0; m < 4; ++m) { bf16* rowp = O + (size_t)(row0 + ai * 128 + m * 16) * 1024 + colt + wc * 32 + 8 * fq;
#pragma unroll
                for (int bj = 0; bj < 2; ++bj) { const f32x4 v0 = acc[ai][bj][m][0] * sc, v1 = acc[ai][bj][m][1] * sc;
                    u32x4 w; w.x = pk2(v0[0], v0[1]); w.y = pk2(v0[2], v0[3]); w.z = pk2(v1[0], v1[1]); w.w = pk2(v1[2], v1[3]);
                    *(u32x4*)(rowp + bj * 128) = w; } }
    }
};
struct EpiResF32 {
    static constexpr bool PERM = false, AFTER_DRAIN = false;
    const float* res; float* C;
    __device__ __forceinline__ void operator()(const pg8::f32x4 (&acc)[2][2][4][2], const pg8::Unit& u, int wr, int wc, int fr, int fq) const {
        const int row0 = u.pm * 256 + wr * 64 + fr, col0 = u.pn * 256 + wc * 32 + 4 * fq;
#pragma unroll
        for (int ai = 0; ai < 2; ++ai)
#pragma unroll
            for (int m = 0; m < 4; ++m) { const size_t ro = (size_t)(row0 + ai * 128 + m * 16) * D_MODEL + col0;
#pragma unroll
                for (int bj = 0; bj < 2; ++bj)
#pragma unroll
                    for (int n = 0; n < 2; ++n) { const f32x4 r = *(const f32x4*)(res + ro + bj * 128 + n * 16); *(f32x4*)(C + ro + bj * 128 + n * 16) = acc[ai][bj][m][n] + r; } }
    }
};
__device__ __forceinline__ float epi_quad_sum(float v) {
    const auto a = __builtin_amdgcn_permlane32_swap(__builtin_bit_cast(unsigned, v), __builtin_bit_cast(unsigned, v), false, false); const unsigned a0 = a[0], a1 = a[1];
    const float m = __builtin_bit_cast(float, a0) + __builtin_bit_cast(float, a1);
    const auto b = __builtin_amdgcn_permlane16_swap(__builtin_bit_cast(unsigned, m), __builtin_bit_cast(unsigned, m), false, false); const unsigned b0 = b[0], b1 = b[1];
    return __builtin_bit_cast(float, b0) + __builtin_bit_cast(float, b1);
}
struct EpiResF32H {
    static constexpr bool PERM = true, AFTER_DRAIN = false;
    const float* res; float* C; bf16* HB; float* SSP; const float* RX;
    __device__ __forceinline__ void operator()(const pg8::f32x4 (&acc)[2][2][4][2], const pg8::Unit& u, int wr, int wc, int fr, int fq) const {
        const int row0 = u.pm * 256 + wr * 64 + fr, col0 = u.pn * 256 + wc * 32 + 8 * fq;
        u32x4 xb[2][4][2]; float rms[2][4];
#pragma unroll
        for (int ai = 0; ai < 2; ++ai)
#pragma unroll
            for (int m = 0; m < 4; ++m) { if (ai == 1 && m >= 2) continue;
                const size_t ro = (size_t)(row0 + ai * 128 + m * 16) * D_MODEL + col0;
                rms[ai][m] = RX[row0 + ai * 128 + m * 16];
#pragma unroll
                for (int bj = 0; bj < 2; ++bj) xb[ai][m][bj] = *(const u32x4*)(HB + ro + bj * 128); }
#pragma unroll
        for (int ai = 0; ai < 2; ++ai) {
            if (ai == 1) {
#pragma unroll
                for (int m = 2; m < 4; ++m) { const size_t ro = (size_t)(row0 + 128 + m * 16) * D_MODEL + col0; rms[1][m] = RX[row0 + 128 + m * 16];
#pragma unroll
                    for (int bj = 0; bj < 2; ++bj) xb[1][m][bj] = *(const u32x4*)(HB + ro + bj * 128); } }
#pragma unroll
            for (int m = 0; m < 4; ++m) { const int row = row0 + ai * 128 + m * 16; const size_t ro = (size_t)row * D_MODEL + col0; float ss = 0.f; const float rs = rms[ai][m];
#pragma unroll
                for (int bj = 0; bj < 2; ++bj) { const u32x4 x8 = xb[ai][m][bj];
                    const f32x4 r0 = (f32x4){bf_lo(x8.x), bf_hi(x8.x), bf_lo(x8.y), bf_hi(x8.y)} * rs, r1 = (f32x4){bf_lo(x8.z), bf_hi(x8.z), bf_lo(x8.w), bf_hi(x8.w)} * rs;
                    const f32x4 h0 = acc[ai][bj][m][0] + r0, h1 = acc[ai][bj][m][1] + r1;
                    u32x4 hb; hb.x = pk2(h0[0], h0[1]); hb.y = pk2(h0[2], h0[3]); hb.z = pk2(h1[0], h1[1]); hb.w = pk2(h1[2], h1[3]); *(u32x4*)(HB + ro + bj * 128) = hb;
                    ss += ((h0[0] * h0[0] + h0[1] * h0[1]) + (h0[2] * h0[2] + h0[3] * h0[3])) + ((h1[0] * h1[0] + h1[1] * h1[1]) + (h1[2] * h1[2] + h1[3] * h1[3])); }
                ss = epi_quad_sum(ss);
                if (fq == 0) SSP[(size_t)row * 32 + u.pn * 4 + wc] = ss; }
        }
    }
};
struct EpiBf16Row {
    static constexpr bool PERM = true, AFTER_DRAIN = false;
    bf16* O; int ldc; const float* SSP; float* R;
    __device__ __forceinline__ void operator()(const pg8::f32x4 (&acc)[2][2][4][2], const pg8::Unit& u, int wr, int wc, int fr, int fq) const {
        const int row0 = u.pm * 256 + wr * 64 + fr, col0 = u.pn * 256 + wc * 32 + 8 * fq;
#pragma unroll
        for (int ai = 0; ai < 2; ++ai)
#pragma unroll
            for (int m = 0; m < 4; ++m) { const int row = row0 + ai * 128 + m * 16;
                const f32x4 p0 = *(const f32x4*)(SSP + (size_t)row * 32 + 8 * fq), p1 = *(const f32x4*)(SSP + (size_t)row * 32 + 8 * fq + 4);
                float ss = ((p0[0] + p0[1]) + (p0[2] + p0[3])) + ((p1[0] + p1[1]) + (p1[2] + p1[3]));
                ss = epi_quad_sum(ss);
                const float rr = 1.0f / sqrtf(ss * (1.f / D_MODEL) + EPS);
                if (u.pn == 0 && wc == 0 && fq == 0) R[row] = rr;
                bf16* rowp = O + (size_t)row * ldc + col0;
#pragma unroll
                for (int bj = 0; bj < 2; ++bj) { const f32x4 v0 = acc[ai][bj][m][0] * rr, v1 = acc[ai][bj][m][1] * rr;
                    u32x4 w; w.x = pk2(v0[0], v0[1]); w.y = pk2(v0[2], v0[3]); w.z = pk2(v1[0], v1[1]); w.w = pk2(v1[2], v1[3]);
                    *(u32x4*)(rowp + bj * 128) = w; } }
    }
};
struct EpiBf16Plain {
    static constexpr bool PERM = true, AFTER_DRAIN = false;
    bf16* O; int ldc;
    __device__ __forceinline__ void operator()(const pg8::f32x4 (&acc)[2][2][4][2], const pg8::Unit& u, int wr, int wc, int fr, int fq) const {
        const int row0 = u.pm * 256 + wr * 64 + fr, col0 = u.pn * 256 + wc * 32 + 8 * fq;
#pragma unroll
        for (int ai = 0; ai < 2; ++ai)
#pragma unroll
            for (int m = 0; m < 4; ++m) { bf16* rowp = O + (size_t)(row0 + ai * 128 + m * 16) * ldc + col0;
#pragma unroll
                for (int bj = 0; bj < 2; ++bj) { const f32x4 v0 = acc[ai][bj][m][0], v1 = acc[ai][bj][m][1];
                    u32x4 w; w.x = pk2(v0[0], v0[1]); w.y = pk2(v0[2], v0[3]); w.z = pk2(v1[0], v1[1]); w.w = pk2(v1[2], v1[3]);
                    *(u32x4*)(rowp + bj * 128) = w; } }
    }
};

__device__ __forceinline__ void transpose_item(const float* W, int K, int N, bf16* WT, int k0, int dst_row0, int src_col0, int nvalid, LAS float* scr, int lane, const float* kscale = nullptr) {
    const int col = lane & 31;
    float v[32];
#pragma unroll
    for (int i = 0; i < 32; ++i) { const int kk = 2 * i + (lane >> 5); v[i] = (col < nvalid) ? W[(size_t)(k0 + kk) * N + src_col0 + col] : 0.f; }
    if (kscale) {
#pragma unroll
        for (int i = 0; i < 32; ++i) v[i] *= kscale[k0 + 2 * i + (lane >> 5)]; }
#pragma unroll
    for (int i = 0; i < 32; ++i) { const int kk = 2 * i + (lane >> 5); scr[kk * 33 + col] = v[i]; }
    LDS_WAIT(); asm volatile("" ::: "memory");
    const int c = lane & 7;
#pragma unroll
    for (int j = 0; j < 4; ++j) { const int n = (lane >> 3) + 8 * j; const LAS float* s = scr + (8 * c) * 33 + n;
        u32x4 o; o.x = pk2(s[0 * 33], s[1 * 33]); o.y = pk2(s[2 * 33], s[3 * 33]); o.z = pk2(s[4 * 33], s[5 * 33]); o.w = pk2(s[6 * 33], s[7 * 33]);
        *(u32x4*)(WT + (size_t)(dst_row0 + n) * K + k0 + 8 * c) = o; }
    LDS_WAIT(); asm volatile("" ::: "memory");
}
__device__ __forceinline__ void row_to_bf16_rstd(const float* xrow, bf16* orow, float* rstd, int lane) {
    const f32x4* xr = (const f32x4*)xrow + lane;
    f32x4 v[8]; float s = 0.f;
#pragma unroll
    for (int j = 0; j < 8; ++j) { v[j] = xr[64 * j]; s += (v[j].x * v[j].x + v[j].y * v[j].y) + (v[j].z * v[j].z + v[j].w * v[j].w); }
    const float rms = sqrtf(wave_sum(s) * (1.f / D_MODEL) + EPS), r = 1.0f / rms;
    if (lane == 0) *rstd = rms;
    u32x2* o8 = (u32x2*)orow + lane;
#pragma unroll
    for (int j = 0; j < 8; ++j) { u32x2 o; o.x = pk2(v[j].x * r, v[j].y * r); o.y = pk2(v[j].z * r, v[j].w * r); o8[64 * j] = o; }
}
__device__ __forceinline__ void rms_row_to_bf16(const float* xrow, const float* w, bf16* orow, int lane) {
    const f32x4* xr = (const f32x4*)xrow + lane; const f32x4* wr = (const f32x4*)w + lane;
    f32x4 v[8]; float s = 0.f;
#pragma unroll
    for (int j = 0; j < 8; ++j) { v[j] = xr[64 * j]; s += (v[j].x * v[j].x + v[j].y * v[j].y) + (v[j].z * v[j].z + v[j].w * v[j].w); }
    const float r = 1.0f / sqrtf(wave_sum(s) * (1.f / D_MODEL) + EPS);
    u32x2* o8 = (u32x2*)orow + lane;
#pragma unroll
    for (int j = 0; j < 8; ++j) { const f32x4 ww = wr[64 * j]; u32x2 o; o.x = pk2(v[j].x * r * ww.x, v[j].y * r * ww.y); o.y = pk2(v[j].z * r * ww.z, v[j].w * r * ww.w); o8[64 * j] = o; }
}
__device__ __forceinline__ void rms_row_to_f32(const float* xrow, const float* w, float* orow, int lane) {
    const f32x4* xr = (const f32x4*)xrow + lane; const f32x4* wr = (const f32x4*)w + lane;
    f32x4 v[8]; float s = 0.f;
#pragma unroll
    for (int j = 0; j < 8; ++j) { v[j] = xr[64 * j]; s += (v[j].x * v[j].x + v[j].y * v[j].y) + (v[j].z * v[j].z + v[j].w * v[j].w); }
    const float r = 1.0f / sqrtf(wave_sum(s) * (1.f / D_MODEL) + EPS);
    f32x4* o = (f32x4*)orow + lane;
#pragma unroll
    for (int j = 0; j < 8; ++j) { const f32x4 ww = wr[64 * j]; o[64 * j] = v[j] * r * ww; }
}
template <int CTRL> __device__ __forceinline__ float dpp_mov_f32(float v) { return __builtin_bit_cast(float, __builtin_amdgcn_update_dpp(0, __builtin_bit_cast(int, v), CTRL, 0xf, 0xf, false)); }
struct FinRaw { u32x4 x[4], d[4]; };
__device__ __forceinline__ void fin_load(const bf16* X, const bf16* Dd, int m, int lane, FinRaw& R, bool sum_in_d) {
    const u32x4* xr = (const u32x4*)(X + (size_t)m * D_MODEL) + lane; const u32x4* dr = (const u32x4*)(Dd + (size_t)m * D_MODEL) + lane;
    if (sum_in_d) {
#pragma unroll
        for (int j = 0; j < 4; ++j) { R.x[j] = (u32x4){0u, 0u, 0u, 0u}; R.d[j] = dr[64 * j]; }
    } else {
#pragma unroll
        for (int j = 0; j < 4; ++j) { R.x[j] = xr[64 * j]; R.d[j] = dr[64 * j]; }
    }
}
__device__ __forceinline__ float fin_wave_sum(float v) {
    v += dpp_mov_f32<0xB1>(v); v += dpp_mov_f32<0x4E>(v); v += dpp_mov_f32<0x141>(v); v += dpp_mov_f32<0x140>(v);
    const auto a = __builtin_amdgcn_permlane16_swap(__builtin_bit_cast(unsigned, v), __builtin_bit_cast(unsigned, v), false, false); const unsigned a0 = a[0], a1 = a[1];
    v = __builtin_bit_cast(float, a0) + __builtin_bit_cast(float, a1);
    const auto b = __builtin_amdgcn_permlane32_swap(__builtin_bit_cast(unsigned, v), __builtin_bit_cast(unsigned, v), false, false); const unsigned b0 = b[0], b1 = b[1];
    return __builtin_bit_cast(float, b0) + __builtin_bit_cast(float, b1);
}
__device__ __forceinline__ void final_norm_rows(const bf16* X, const bf16* Dd, const float* w, float* out, int m0, int stride, int lane, bool sum_in_d) {
    if (m0 >= T_TOK) return;
    f32x4 ww[4][2];
#pragma unroll
    for (int j = 0; j < 4; ++j) { ww[j][0] = *((const f32x4*)(w + 512 * j + 8 * lane)); ww[j][1] = *((const f32x4*)(w + 512 * j + 8 * lane + 4)); }
    FinRaw R; fin_load(X, Dd, m0, lane, R, sum_in_d);
    for (int m = m0; m < T_TOK; m += stride) {
        f32x4 v[4][2]; float s = 0.f;
#pragma unroll
        for (int j = 0; j < 4; ++j) { const u32x4 xx = R.x[j], d = R.d[j];
            v[j][0] = (f32x4){bf_lo(xx.x) + bf_lo(d.x), bf_hi(xx.x) + bf_hi(d.x), bf_lo(xx.y) + bf_lo(d.y), bf_hi(xx.y) + bf_hi(d.y)};
            v[j][1] = (f32x4){bf_lo(xx.z) + bf_lo(d.z), bf_hi(xx.z) + bf_hi(d.z), bf_lo(xx.w) + bf_lo(d.w), bf_hi(xx.w) + bf_hi(d.w)};
            s += ((v[j][0].x * v[j][0].x + v[j][0].y * v[j][0].y) + (v[j][0].z * v[j][0].z + v[j][0].w * v[j][0].w)) + ((v[j][1].x * v[j][1].x + v[j][1].y * v[j][1].y) + (v[j][1].z * v[j][1].z + v[j][1].w * v[j][1].w)); }
        if (m + stride < T_TOK) fin_load(X, Dd, m + stride, lane, R, sum_in_d);
        const float r = 1.0f / sqrtf(fin_wave_sum(s) * (1.f / D_MODEL) + EPS);
        float* orow = out + (size_t)m * D_MODEL + 8 * lane;
#pragma unroll
        for (int j = 0; j < 4; ++j) { *(f32x4*)(orow + 512 * j) = v[j][0] * r * ww[j][0]; *(f32x4*)(orow + 512 * j + 4) = v[j][1] * r * ww[j][1]; }
    }
}
__device__ __forceinline__ void convert_bf16(const float* src, bf16* dst, size_t n, size_t gtid, size_t gthreads) {
    const size_t n8 = n / 8;
    for (size_t i0 = gtid; i0 < n8; i0 += 4 * gthreads) {
        f32x4 a[4], b[4];
#pragma unroll
        for (int u = 0; u < 4; ++u) { const size_t i = i0 + u * gthreads; if (i < n8) { a[u] = __builtin_nontemporal_load((const f32x4*)(src + 8 * i)); b[u] = __builtin_nontemporal_load((const f32x4*)(src + 8 * i + 4)); } }
#pragma unroll
        for (int u = 0; u < 4; ++u) { const size_t i = i0 + u * gthreads; if (i < n8) { u32x4 o; o.x = pk2(a[u].x, a[u].y); o.y = pk2(a[u].z, a[u].w); o.z = pk2(b[u].x, b[u].y); o.w = pk2(b[u].z, b[u].w); *(u32x4*)(dst + 8 * i) = o; } }
    }
}

__device__ __forceinline__ unsigned pk4_fp8(f32x4 v, float sc) { int r = 0; r = __builtin_amdgcn_cvt_pk_fp8_f32(v.x * sc, v.y * sc, r, false); r = __builtin_amdgcn_cvt_pk_fp8_f32(v.z * sc, v.w * sc, r, true); return (unsigned)r; }
__device__ __forceinline__ unsigned pk4_i8(f32x4 v, float s) {
    const auto a = __builtin_amdgcn_cvt_pknorm_i16(v.x * s, v.y * s), b = __builtin_amdgcn_cvt_pknorm_i16(v.z * s, v.w * s);
    return __builtin_amdgcn_perm(__builtin_bit_cast(unsigned, b), __builtin_bit_cast(unsigned, a), 0x06040200u);
}
__device__ __forceinline__ void convert_i8_rows(const float* src, unsigned char* dst, float* usc, int gw, int NGW, int lane, const float* cscale, int e_begin = 0, int e_end = N_EXPERTS) {
    for (int e = e_begin + gw; e < e_end; e += NGW) {
        f32x4 a[8];
#pragma unroll
        for (int k = 0; k < 8; ++k) a[k] = __builtin_nontemporal_load((const f32x4*)(src + (size_t)e * D_MODEL) + k * 64 + lane);
        float mx = 0.f;
#pragma unroll
        for (int k = 0; k < 8; ++k) { if (cscale) a[k] = a[k] * *(const f32x4*)(cscale + 4 * (k * 64 + lane)); mx = fmaxf(fmaxf(fmaxf(fabsf(a[k].x), fabsf(a[k].y)), fmaxf(fabsf(a[k].z), fabsf(a[k].w))), mx); }
        mx = fmaxf(mx, dpp_mov_f32<0xB1>(mx)); mx = fmaxf(mx, dpp_mov_f32<0x4E>(mx)); mx = fmaxf(mx, dpp_mov_f32<0x141>(mx)); mx = fmaxf(mx, dpp_mov_f32<0x140>(mx));
        { const auto s1 = __builtin_amdgcn_permlane16_swap(__builtin_bit_cast(unsigned, mx), __builtin_bit_cast(unsigned, mx), false, false); const unsigned p0 = s1[0], p1 = s1[1]; mx = fmaxf(__builtin_bit_cast(float, p0), __builtin_bit_cast(float, p1)); }
        { const auto s2 = __builtin_amdgcn_permlane32_swap(__builtin_bit_cast(unsigned, mx), __builtin_bit_cast(unsigned, mx), false, false); const unsigned p0 = s2[0], p1 = s2[1]; mx = fmaxf(__builtin_bit_cast(float, p0), __builtin_bit_cast(float, p1)); }
        const float s = mx > 1e-30f ? (127.f / 32767.f) / mx : 0.f;
        if (lane == 0) usc[e] = mx * (1.f / 127.f);
#pragma unroll
        for (int k = 0; k < 8; ++k) { const int jd = k * 64 + lane, sl = jd >> 5, cd = jd & 31;
            *(unsigned*)(dst + ((size_t)sl * N_EXPERTS + e) * 128 + cd * 4) = pk4_i8(a[k], s); }
    }
}
__device__ __forceinline__ void convert_fp8_sliced(const float* src, unsigned char* dst, float sc, int gw, int NGW, int lane, const float* cscale = nullptr, int h_begin = 0, int h_end = N_EXPERTS * 2) {
    const int NHALF = h_end;
    for (int h0 = h_begin + gw; h0 < NHALF; h0 += 2 * NGW) {
        f32x4 a[2][4];
#pragma unroll
        for (int u = 0; u < 2; ++u) { const int hr = h0 + u * NGW; if (hr < NHALF) {
#pragma unroll
            for (int k = 0; k < 4; ++k) a[u][k] = __builtin_nontemporal_load((const f32x4*)(src + (size_t)hr * 1024) + k * 64 + lane); } }
#pragma unroll
        for (int u = 0; u < 2; ++u) { const int hr = h0 + u * NGW; if (hr < NHALF) {
            const int e = hr >> 1, hf = hr & 1;
#pragma unroll
            for (int k = 0; k < 4; ++k) { const int jd = hf * 256 + k * 64 + lane, sl = jd >> 5, cd = jd & 31;
                f32x4 v = a[u][k]; if (cscale) v = v * *(const f32x4*)(cscale + 4 * jd);
                *(unsigned*)(dst + ((size_t)sl * N_EXPERTS + e) * 128 + cd * 4) = pk4_fp8(v, sc); } } }
    }
}

__device__ __forceinline__ void square_transposes(const Params& p, LAS unsigned char* lds, int w0, int nw, int lane, int wave) {
    unsigned char* ws = p.ws;
    LAS float* scr = (LAS float*)(lds + wave * 16384);
    constexpr int IT_SQ = 32 * 64;
    for (int it = w0; it < 2 * IT_SQ; it += nw) {
        int r = it;
        if (r < IT_SQ) { transpose_item(p.in[I_WOUT], D_MODEL, D_MODEL, (bf16*)(ws + WS_WOUT_T), (r / 64) * 64, (r % 64) * 32, (r % 64) * 32, 32, scr, lane); continue; }
        r -= IT_SQ;
        transpose_item(p.in[I_PWQ], D_MODEL, D_MODEL, (bf16*)(ws + WS_WQ_T), (r / 64) * 64, (r % 64) * 32, (r % 64) * 32, 32, scr, lane, p.in[I_FNW]);
    }
}
__device__ __forceinline__ void phase_prologue(const Params& p, LAS unsigned char* lds, int tid, int lane, int wave) {
    unsigned char* ws = p.ws;
    LAS float* scr = (LAS float*)(lds + wave * 16384);
    const int gw = blockIdx.x * NWAVES + wave, NGW = gridDim.x * NWAVES;
    constexpr int IT_IN = 32 * (N_IN_PAD / 32), IT_SQ = 32 * 64, IT_WC = 64 * 4;
    const int NITEMS = IT_IN + ((gridDim.x >= 256) ? 0 : 2 * IT_SQ);
    for (int it = gw; it < NITEMS; it += NGW) {
        int r = it;
        if (r < IT_IN) { const int nb = r % (N_IN_PAD / 32), kb = r / (N_IN_PAD / 32); const int n0 = nb * 32;
            int src, nvalid = 32;
            if (n0 < 2560) src = n0; else if (n0 < 5632) src = n0 + 24; else { src = 2560 + (n0 - 5632); nvalid = (n0 == 5632) ? 24 : 0; if (nvalid == 0) src = 0; }
            transpose_item(p.in[I_WIN], D_MODEL, N_IN, (bf16*)(ws + WS_WIN_T), kb * 64, n0, src, nvalid, scr, lane, p.in[I_ANW]); continue; }
        r -= IT_IN;
        if (r < IT_SQ) { transpose_item(p.in[I_WOUT], D_MODEL, D_MODEL, (bf16*)(ws + WS_WOUT_T), (r / 64) * 64, (r % 64) * 32, (r % 64) * 32, 32, scr, lane); continue; }
        r -= IT_SQ;
        transpose_item(p.in[I_PWQ], D_MODEL, D_MODEL, (bf16*)(ws + WS_WQ_T), (r / 64) * 64, (r % 64) * 32, (r % 64) * 32, 32, scr, lane, p.in[I_FNW]);
    }
    for (int ch = blockIdx.x * NTHREADS + tid; ch < 131072; ch += gridDim.x * NTHREADS) {
        const int ln = ch & 63, c = (ch >> 6) & 7, hh = (ch >> 9) & 1, pp = (ch >> 10) & 7, w = (ch >> 13) & 7, kv = ch >> 16;
        const int kk0 = 512 * w + 64 * pp + 16 * (ln >> 4) + 8 * hh, e = 16 * c + (ln & 15);
        const float* W = p.in[kv ? I_WCV : I_WCK] + (size_t)kk0 * 128 + e;
        u32x4 o; o.x = pk2(W[0], W[128]); o.y = pk2(W[256], W[384]); o.z = pk2(W[512], W[640]); o.w = pk2(W[768], W[896]);
        *((u32x4*)(ws + WS_WCK_T) + ch) = o;
    }
    for (int m = gw; m < T_TOK; m += NGW) row_to_bf16_rstd(p.in[I_X] + (size_t)m * D_MODEL, (bf16*)(ws + WS_XN) + (size_t)m * D_MODEL, (float*)(ws + WS_RX) + m, lane);
    const size_t gtid = (size_t)blockIdx.x * NTHREADS + tid, gthreads = (size_t)gridDim.x * NTHREADS;
    convert_i8_rows(p.in[I_PU], ws + WS_U, (float*)(ws + WS_USC), gw, NGW, lane, p.in[I_FNW], 0, U_ROWS_P0);
    if (V_HALF_P0 > 0) convert_i8_rows(p.in[I_PV], ws + WS_V, (float*)(ws + WS_VSC), gw, NGW, lane, nullptr, 0, V_HALF_P0 / 2);
    convert_bf16(p.in[I_PSK], (bf16*)(ws + WS_SK), (size_t)8 * 2 * 128 * 128, gtid, gthreads);
    for (int ub = blockIdx.x; ub < 256; ub += gridDim.x) {
        const int kv = ub & 1, j = ub >> 1;
        const float* W = p.in[kv == 0 ? I_WCK : I_WCV]; const float* cp = p.in[I_CPOS];
        const int e = tid & 127, sub = tid >> 7; float s = 0.f;
#pragma unroll
        for (int i = 0; i < 8; ++i) { const int kk = j * 32 + sub * 8 + i; s += cp[kk] * W[(size_t)kk * 128 + e]; }
        LAS float* red = (LAS float*)(lds + 8 * 16384);
        __syncthreads();
        red[tid] = s; __syncthreads();
        if (tid < 128) ((float*)(ws + WS_CCONST))[(j * 2 + kv) * 128 + tid] = (red[tid] + red[tid + 128]) + (red[tid + 256] + red[tid + 384]);
    }
}

struct ConvRaw { u32x4 c[3][2], h[3][2], b[2]; };
__device__ __forceinline__ void conv_load(const Params& p, int m, int lane, ConvRaw& R) {
    unsigned char* ws = p.ws;
    const bf16* BG = (const bf16*)(ws + WS_BG); const bf16* CG = (const bf16*)(ws + WS_CG); const bf16* HC = (const bf16*)(ws + WS_HC);
    const int s = m & (SEQ - 1), c0 = 16 * lane;
#pragma unroll
    for (int k = 0; k < 3; ++k) {
        const int back = (s - (2 - k) >= 0) ? 2 - k : 0;
        const size_t o = (size_t)(m - back) * D_CONV + c0;
        R.c[k][0] = *(const u32x4*)(CG + o); R.c[k][1] = *(const u32x4*)(CG + o + 8); R.h[k][0] = *(const u32x4*)(HC + o); R.h[k][1] = *(const u32x4*)(HC + o + 8);
    }
    const size_t o = (size_t)m * D_CONV + c0;
    R.b[0] = *(const u32x4*)(BG + o); R.b[1] = *(const u32x4*)(BG + o + 8);
}
struct ConvW { f32x4 w0[4], w1[4], w2[4], bv[4], g[4]; };
struct ConvU { float u[3][16], bg[16]; };
__device__ __forceinline__ void conv_convert(int m, const ConvRaw& R, ConvU& U) {
    const int s = m & (SEQ - 1);
    float (&u)[3][16] = U.u; float (&bg)[16] = U.bg;
#pragma unroll
    for (int k = 0; k < 3; ++k) {
        const float keep = (s - (2 - k) >= 0) ? 1.f : 0.f;
#pragma unroll
        for (int hh = 0; hh < 2; ++hh)
#pragma unroll
            for (int j = 0; j < 4; ++j) { u[k][8 * hh + 2 * j] = bf_lo(R.c[k][hh][j]) * bf_lo(R.h[k][hh][j]) * keep; u[k][8 * hh + 2 * j + 1] = bf_hi(R.c[k][hh][j]) * bf_hi(R.h[k][hh][j]) * keep; }
    }
#pragma unroll
    for (int j = 0; j < 4; ++j) { bg[2 * j] = bf_lo(R.b[0][j]); bg[2 * j + 1] = bf_hi(R.b[0][j]); bg[8 + 2 * j] = bf_lo(R.b[1][j]); bg[8 + 2 * j + 1] = bf_hi(R.b[1][j]); }
}
__device__ __forceinline__ void conv_finish(const Params& p, int m, int lane, const ConvU& U, const ConvW& W) {
    unsigned char* ws = p.ws;
    const int c0 = 16 * lane;
    const float (&u)[3][16] = U.u; const float (&bg)[16] = U.bg;
    float y[16]; float ss = 0.f;
#pragma unroll
    for (int j4 = 0; j4 < 4; ++j4)
#pragma unroll
        for (int j = 0; j < 4; ++j) { const int c = 4 * j4 + j; const float yy = (W.w0[j4][j] * u[0][c] + W.w1[j4][j] * u[1][c] + W.w2[j4][j] * u[2][c] + W.bv[j4][j]) * bg[c]; y[c] = yy; ss += yy * yy; }
    ss += dpp_mov_f32<0xB1>(ss); ss += dpp_mov_f32<0x4E>(ss); ss += dpp_mov_f32<0x141>(ss);
    const float r = 1.0f / sqrtf(ss * (1.f / 128.f) + EPS);
    bf16* MX = (bf16*)(ws + WS_MIXED) + (size_t)m * D_MODEL + D_ATTN + c0;
    u32x4 o0, o1;
#pragma unroll
    for (int j4 = 0; j4 < 4; ++j4) { const f32x4 g = W.g[j4];
        const unsigned a = pk2(y[4 * j4] * r * g[0], y[4 * j4 + 1] * r * g[1]), b = pk2(y[4 * j4 + 2] * r * g[2], y[4 * j4 + 3] * r * g[3]);
        if (j4 == 0) { o0.x = a; o0.y = b; } else if (j4 == 1) { o0.z = a; o0.w = b; } else if (j4 == 2) { o1.x = a; o1.y = b; } else { o1.z = a; o1.w = b; } }
    *(u32x4*)MX = o0; *(u32x4*)(MX + 8) = o1;
}
__device__ __forceinline__ void conv_tokens(const Params& p, int m0, int stride, int lane) {
    if (m0 >= T_TOK) return;
    const int c0 = 16 * lane;
    ConvW W;
#pragma unroll
    for (int j4 = 0; j4 < 4; ++j4) { W.w0[j4] = *(const f32x4*)(p.in[I_CW] + c0 + 4 * j4); W.w1[j4] = *(const f32x4*)(p.in[I_CW] + D_CONV + c0 + 4 * j4); W.w2[j4] = *(const f32x4*)(p.in[I_CW] + 2 * D_CONV + c0 + 4 * j4);
        W.bv[j4] = *(const f32x4*)(p.in[I_CB] + c0 + 4 * j4); W.g[j4] = *(const f32x4*)(p.in[I_CGNW] + c0 + 4 * j4); }
    ConvRaw A;
    conv_load(p, m0, lane, A);
    for (int m = m0; m < T_TOK; m += stride) {
        ConvU U; conv_convert(m, A, U);
        if (m + stride < T_TOK) conv_load(p, m + stride, lane, A);
        conv_finish(p, m, lane, U, W);
    }
}
__device__ __forceinline__ void conv_token(const Params& p, int m, int lane) { conv_tokens(p, m, T_TOK, lane); }
__device__ __forceinline__ float compress_cconst(const Params& p, int unit, int tid) {
    const int kv = unit >> 6;
    const float* ccp = (const float*)(p.ws + WS_CCONST) + kv * 128 + (tid & 127);
    float c4[4] = {0.f, 0.f, 0.f, 0.f};
#pragma unroll
    for (int j = 0; j < 128; ++j) c4[j & 3] += ccp[j * 256];
    return (c4[0] + c4[1]) + (c4[2] + c4[3]);
}
__device__ __forceinline__ void compress_unit(const Params& p, LAS unsigned char* lds, int unit, int tid, int lane, int wave, float ccv) {
    unsigned char* ws = p.ws;
    const int nt = unit & 15, h = (unit >> 4) & 1, b = (unit >> 5) & 1, kv = unit >> 6;
    const bf16* src = (const bf16*)(ws + (kv ? WS_VC : WS_KC)) + (size_t)(b * 2 + h) * SEQ * 128;
    const int r = lane & 15, q = lane >> 4;
    int n = nt * 16 + r; if (n > 254) n = 254;
    const bf16* arow = src + (size_t)n * 16 * 128 + wave * 512 + 16 * q;
    const bf16x8* bfr = (const bf16x8*)(ws + WS_WCK_T) + ((size_t)(kv * 8 + wave) * 128) * 64 + lane;
    f32x4 acc[8];
#pragma unroll
    for (int c = 0; c < 8; ++c) acc[c] = (f32x4){0.f, 0.f, 0.f, 0.f};
#pragma unroll 2
    for (int pp = 0; pp < 8; ++pp) {
        const bf16x8 a0 = *(const bf16x8*)(arow + pp * 64), a1 = *(const bf16x8*)(arow + pp * 64 + 8);
        bf16x8 bb[16];
#pragma unroll
        for (int c = 0; c < 16; ++c) bb[c] = bfr[(size_t)(pp * 16 + c) * 64];
#pragma unroll
        for (int c = 0; c < 8; ++c) { acc[c] = __builtin_amdgcn_mfma_f32_16x16x32_bf16(a0, bb[c], acc[c], 0, 0, 0); acc[c] = __builtin_amdgcn_mfma_f32_16x16x32_bf16(a1, bb[8 + c], acc[c], 0, 0, 0); }
    }
    LAS float* red = (LAS float*)lds;
#pragma unroll
    for (int c = 0; c < 8; ++c)
#pragma unroll
        for (int j = 0; j < 4; ++j) red[wave * 2048 + (4 * q + j) * 128 + 16 * c + r] = acc[c][j];
    __syncthreads();
#pragma unroll
    for (int k = 0; k < 4; ++k) {
        const int o = tid + 512 * k, nn = o >> 7, e = o & 127;
        float s = 0.f;
#pragma unroll
        for (int w = 0; w < 8; ++w) s += red[w * 2048 + o];
        s += ccv;
        const int ng = nt * 16 + nn;
        if (ng > 254) s = 0.f;
        if (kv == 0) ((bf16*)(ws + WS_KCMP))[((size_t)(b * 2 + h) * 256 + ng) * 128 + e] = (bf16)f2bf(s);
        else ((bf16*)(ws + WS_VCMPT))[((size_t)(b * 2 + h) * 128 + e) * 256 + ng] = (bf16)f2bf(s);
    }
    __syncthreads();
}

constexpr int AT_KBUF = 16384, AT_VBUF = 128 * 128, AT_BUF = AT_KBUF + AT_VBUF;
constexpr int AT_OFF_IMP = 2 * AT_BUF;
constexpr int AT_OFF_SC = AT_OFF_IMP + 32768;
constexpr int AT_OFF_PARK = 2 * AT_BUF;
constexpr int AT_OFF_LUT = AT_OFF_PARK + 65536;
constexpr int AT_OFF_MASK = AT_OFF_LUT + 2048;
static_assert(AT_OFF_SC + 8192 <= AT_OFF_LUT && AT_OFF_MASK + 256 <= LDS_CTL_OFF, "attention LDS map");
typedef unsigned long long u64;

__device__ __forceinline__ void at_load_k(u32x4 (&kr)[2], const bf16* ktile, int tid) {
    const u32x4* s = (const u32x4*)(ktile + (size_t)(tid >> 3) * 128 + (tid & 7) * 16); kr[0] = s[0]; kr[1] = s[1];
}
__device__ __forceinline__ void at_store_k(const u32x4 (&kr)[2], LAS unsigned char* kb, int tid) {
    const int row = tid >> 3, c0 = (tid & 7) * 2, sk = (row & 3) | (((row >> 3) & 3) << 2);
    *(LAS u32x4*)(kb + row * 256 + (((c0) ^ sk) << 4)) = kr[0];
    *(LAS u32x4*)(kb + row * 256 + (((c0 + 1) ^ sk) << 4)) = kr[1];
}
__device__ __forceinline__ void at_load_v(u32x4 (&vr)[2], const bf16* vt, size_t vstride, int tid) {
    const u32x4* s = (const u32x4*)(vt + (size_t)(tid >> 2) * vstride + (tid & 3) * 16); vr[0] = s[0]; vr[1] = s[1];
}
__device__ __forceinline__ void at_store_v(const u32x4 (&vr)[2], LAS unsigned char* vb, int tid) {
    const int row = tid >> 2, c0 = (tid & 3) * 2, f = (row >> 1) & 7;
    *(LAS u32x4*)(vb + row * 128 + ((c0 ^ f) << 4)) = vr[0];
    *(LAS u32x4*)(vb + row * 128 + (((c0 + 1) ^ f) << 4)) = vr[1];
}
__device__ __forceinline__ void at_qk_load(const LAS unsigned char* kb, bf16x8 (&a)[16], int r, int q) {
#pragma unroll
    for (int ks = 0; ks < 4; ++ks)
#pragma unroll
        for (int mt = 0; mt < 4; ++mt)
            a[4 * ks + mt] = *(const LAS bf16x8*)(kb + (32 * (mt >> 1) + 8 * (r >> 2) + 4 * (mt & 1) + (r & 3)) * 256 + (((4 * ks + q) ^ r) << 4));
}
__device__ __forceinline__ void at_qk_mma(const bf16x8 (&a)[16], const bf16x8 (&Qf)[4], f32x4 (&S)[4], float c0) {
#pragma unroll
    for (int mt = 0; mt < 4; ++mt) S[mt] = (f32x4){c0, c0, c0, c0};
#pragma unroll
    for (int ks = 0; ks < 4; ++ks)
#pragma unroll
        for (int mt = 0; mt < 4; ++mt) S[mt] = __builtin_amdgcn_mfma_f32_16x16x32_bf16(a[4 * ks + mt], Qf[ks], S[mt], 0, 0, 0);
}
__device__ __forceinline__ void at_qk(const LAS unsigned char* kb, const bf16x8 (&Qf)[4], f32x4 (&S)[4], int r, int q, float c0 = 0.f) {
    bf16x8 a[16];
    at_qk_load(kb, a, r, q);
    __builtin_amdgcn_sched_barrier(0);
    at_qk_mma(a, Qf, S, c0);
}
__device__ __forceinline__ void at_pv_load(const LAS unsigned char* vb, bf16x8 (&v)[16], int r, int q) {
#pragma unroll
    for (int k2 = 0; k2 < 2; ++k2)
#pragma unroll
        for (int dt = 0; dt < 8; ++dt)
            v[8 * k2 + dt] = *(const LAS bf16x8*)(vb + (16 * dt + r) * 128 + (((4 * k2 + q) ^ ((r >> 1) & 7)) << 4));
}
__device__ __forceinline__ void at_pv_mma(const bf16x8 (&v)[16], const f32x4 (&P)[4], f32x4 (&O)[8]) {
    bf16x8 pf[2];
#pragma unroll
    for (int k2 = 0; k2 < 2; ++k2) {
        u32x4 w; w.x = pk2(P[2 * k2][0], P[2 * k2][1]); w.y = pk2(P[2 * k2][2], P[2 * k2][3]); w.z = pk2(P[2 * k2 + 1][0], P[2 * k2 + 1][1]); w.w = pk2(P[2 * k2 + 1][2], P[2 * k2 + 1][3]);
        pf[k2] = __builtin_bit_cast(bf16x8, w);
    }
#pragma unroll
    for (int k2 = 0; k2 < 2; ++k2)
#pragma unroll
        for (int dt = 0; dt < 8; ++dt) O[dt] = __builtin_amdgcn_mfma_f32_16x16x32_bf16(v[8 * k2 + dt], pf[k2], O[dt], 0, 0, 0);
}
__device__ __forceinline__ void at_pv(const LAS unsigned char* vb, const f32x4 (&P)[4], f32x4 (&O)[8], int r, int q) {
    bf16x8 v[16];
    at_pv_load(vb, v, r, q);
    __builtin_amdgcn_sched_barrier(0);
    at_pv_mma(v, P, O);
}
__device__ __forceinline__ float at_u2f(unsigned u) { return __builtin_bit_cast(float, u); }
__device__ __forceinline__ unsigned at_f2u(float f) { return __builtin_bit_cast(unsigned, f); }
__device__ __forceinline__ float quad_max(float v) {
    const auto a = __builtin_amdgcn_permlane32_swap(at_f2u(v), at_f2u(v), false, false); const unsigned a0 = a[0], a1 = a[1];
    const float m = fmaxf(at_u2f(a0), at_u2f(a1));
    const auto b = __builtin_amdgcn_permlane16_swap(at_f2u(m), at_f2u(m), false, false); const unsigned b0 = b[0], b1 = b[1];
    return fmaxf(at_u2f(b0), at_u2f(b1));
}
__device__ __forceinline__ float quad_sum(float v) {
    const auto a = __builtin_amdgcn_permlane32_swap(at_f2u(v), at_f2u(v), false, false); const unsigned a0 = a[0], a1 = a[1];
    const float m = at_u2f(a0) + at_u2f(a1);
    const auto b = __builtin_amdgcn_permlane16_swap(at_f2u(m), at_f2u(m), false, false); const unsigned b0 = b[0], b1 = b[1];
    return at_u2f(b0) + at_u2f(b1);
}

__device__ __forceinline__ void at_gld16(u32x4& d, unsigned voff, const void* sbase) { asm volatile("global_load_dwordx4 %0, %1, %2" : "=v"(d) : "v"(voff), "s"(sbase) : "memory"); }
template <int N> __device__ __forceinline__ void at_vmwait(u32x4& a, u32x4& b, u32x4& c, u32x4& d) { asm volatile("s_waitcnt vmcnt(%4)" : "+v"(a), "+v"(b), "+v"(c), "+v"(d) : "n"(N) : "memory"); }
__device__ __forceinline__ void at_issue_tile(u32x4 (&kr)[2], u32x4 (&vr)[2], const bf16* Kg, const bf16* Vtg, int j, unsigned koff, unsigned voff) {
    j = __builtin_amdgcn_readfirstlane(j);
    const void* kb = Kg + (size_t)j * 64 * 128; const void* vb = Vtg + (size_t)j * 64;
    at_gld16(kr[0], koff, kb); at_gld16(kr[1], koff + 16u, kb); at_gld16(vr[0], voff, vb); at_gld16(vr[1], voff + 16u, vb);
}
template <int MODE> __device__ __forceinline__ int at_next(int j, int j_hi, u64 active) {
    int jn = j + 1;
    if (MODE == 0) { while (jn <= j_hi && !((active >> jn) & 1ull)) ++jn; }
    return jn;
}
constexpr float AT_THR = 8.0f;
__device__ __forceinline__ float at_max3(float a, float b, float c) { float r; asm("v_max3_f32 %0, %1, %2, %3" : "=v"(r) : "v"(a), "v"(b), "v"(c)); return r; }
template <int MODE>
__device__ __forceinline__ void at_tile(LAS unsigned char* lds, int stage, int j, u64 mymask, u64 wavemask, int t, int tw_min, const LAS float* lut, const bf16x8 (&Qf)[4], f32x4 (&O)[8], float& m, float& l, int r, int q) {
    if (MODE == 0 && !((wavemask >> j) & 1ull)) return;
    const LAS unsigned char* kb = lds + stage * AT_BUF; const LAS unsigned char* vb = kb + AT_KBUF;
    const bool rowok = (MODE == 0) ? (((mymask >> j) & 1ull) != 0ull) : true;
    const bool far = (tw_min - (64 * j + 63) >= 127) && (MODE == 0 || (tw_min + 3 - 64 * j) < 512);
    f32x4 S[4];
    if (far) {
        at_qk(kb, Qf, S, r, q, rowok ? lut[127] - m : -INFINITY);
    } else {
        at_qk(kb, Qf, S, r, q);
        const int d0 = t - 64 * j - 8 * q;
#pragma unroll
        for (int mt = 0; mt < 4; ++mt)
#pragma unroll
            for (int jj = 0; jj < 4; ++jj) {
                const int dist = d0 - (32 * (mt >> 1) + 4 * (mt & 1)) - jj;
                const bool ok = rowok && dist >= 0 && (MODE == 0 || dist < 512);
                const int di = dist < 0 ? 0 : (dist > 127 ? 127 : dist);
                const float bv = ((const volatile LAS float*)lut)[di];
                S[mt][jj] = ok ? S[mt][jj] + (bv - m) : -INFINITY;
            }
    }
    float mx = at_max3(S[0][0], S[0][1], S[0][2]);
    mx = at_max3(mx, S[0][3], S[1][0]); mx = at_max3(mx, S[1][1], S[1][2]); mx = at_max3(mx, S[1][3], S[2][0]); mx = at_max3(mx, S[2][1], S[2][2]);
    mx = at_max3(mx, S[2][3], S[3][0]); mx = at_max3(mx, S[3][1], S[3][2]); mx = at_max3(mx, S[3][3], S[3][3]);
    if (__builtin_amdgcn_ballot_w64(mx > AT_THR) != 0ull) {
        const float up = fmaxf(quad_max(mx), 0.f);
        const float f = __builtin_amdgcn_exp2f(-up);
        m += up; l *= f;
#pragma unroll
        for (int dt = 0; dt < 8; ++dt) O[dt] = O[dt] * f;
#pragma unroll
        for (int mt = 0; mt < 4; ++mt) S[mt] = S[mt] - up;
    }
    float ps = 0.f;
#pragma unroll
    for (int mt = 0; mt < 4; ++mt)
#pragma unroll
        for (int jj = 0; jj < 4; ++jj) { const float pv = __builtin_amdgcn_exp2f(S[mt][jj]); S[mt][jj] = pv; ps += pv; }
    l += ps;
    at_pv(vb, S, O, r, q);
}
template <int MODE>
__device__ __forceinline__ void attn_branch(LAS unsigned char* lds, const bf16* Kg, const bf16* Vtg, int j_lo, int j_hi, u64 active, u64 mymask, u64 wavemask, int t, int g,
                                            const bf16x8 (&Qf)[4], f32x4 (&O)[8], float& m, float& l, int tid, int r, int q) {
    asm volatile("" : "+v"(tid), "+v"(r), "+v"(q));
    const LAS float* lut = (const LAS float*)(lds + AT_OFF_LUT) + g * 128;
    const int tw_min = t - (r >> 2);
    wavemask = ((u64)(unsigned)__builtin_amdgcn_readfirstlane((int)(unsigned)(wavemask >> 32)) << 32) | (unsigned)__builtin_amdgcn_readfirstlane((int)(unsigned)wavemask);
    active = ((u64)(unsigned)__builtin_amdgcn_readfirstlane((int)(unsigned)(active >> 32)) << 32) | (unsigned)__builtin_amdgcn_readfirstlane((int)(unsigned)active);
    j_lo = __builtin_amdgcn_readfirstlane(j_lo); j_hi = __builtin_amdgcn_readfirstlane(j_hi);
    const int w = __builtin_amdgcn_readfirstlane(tid >> 6), ln = tid & 63;
    unsigned kof[2], vof[2];
#pragma unroll
    for (int i = 0; i < 2; ++i) {
        const int kr = 8 * w + 4 * i + (ln >> 4), sk = (kr & 3) | (((kr >> 3) & 3) << 2); kof[i] = (unsigned)((kr * 128 + (((ln & 15) ^ sk) << 3)) * 2);
        const int vr = 16 * w + 8 * i + (ln >> 3), f = (vr >> 1) & 7; vof[i] = (unsigned)((vr * SEQ + (((ln & 7) ^ f) << 3)) * 2);
    }
    const int kl = 8 * w * 256, vl = AT_KBUF + 16 * w * 128;
#define AT_DMA(stage, j) do { const char* kb_ = (const char*)(Kg + (size_t)(j) * 64 * 128); const char* vb_ = (const char*)(Vtg + (size_t)(j) * 64); \
        _Pragma("unroll") for (int i_ = 0; i_ < 2; ++i_) __builtin_amdgcn_global_load_lds((const unsigned*)(kb_ + kof[i_]), (LAS unsigned*)(lds + (stage) * AT_BUF + kl + i_ * 1024), 16, 0, 0); \
        _Pragma("unroll") for (int i_ = 0; i_ < 2; ++i_) __builtin_amdgcn_global_load_lds((const unsigned*)(vb_ + vof[i_]), (LAS unsigned*)(lds + (stage) * AT_BUF + vl + i_ * 1024), 16, 0, 0); } while (0)
    int j0 = j_lo, j1;
    AT_DMA(0, j0);
    for (;;) {
        asm volatile("s_waitcnt vmcnt(0)" ::: "memory");
        __syncthreads();
        j1 = at_next<MODE>(j0, j_hi, active);
        if (j1 <= j_hi) AT_DMA(1, j1);
        at_tile<MODE>(lds, 0, j0, mymask, wavemask, t, tw_min, lut, Qf, O, m, l, r, q);
        if (j1 > j_hi) break;
        j0 = j1;
        asm volatile("s_waitcnt vmcnt(0)" ::: "memory");
        __syncthreads();
        j1 = at_next<MODE>(j0, j_hi, active);
        if (j1 <= j_hi) AT_DMA(0, j1);
        at_tile<MODE>(lds, 1, j0, mymask, wavemask, t, tw_min, lut, Qf, O, m, l, r, q);
        if (j1 > j_hi) break;
        j0 = j1;
    }
#undef AT_DMA
    __syncthreads();
}

__device__ __forceinline__ void attn_unit(const Params& p, LAS unsigned char* lds, int unit, int tid, int lane, int wave) {
    asm volatile("" : "+v"(tid), "+v"(lane));
    unsigned char* ws = p.ws;
    const int bh = unit & 3, qt = 127 - (unit >> 2), b = bh >> 1, h = bh & 1;
    const int T0 = qt * 32, jt = T0 >> 6;
    const int r = lane & 15, q = lane >> 4, g = r & 3;
    const int tok = 4 * wave + (r >> 2), t = T0 + tok;
    const size_t mrow = (size_t)b * SEQ + t;
    const int hq = h * 4 + g;
    const int kt_max = (T0 >> 4) >> 6;
    const int dw = __builtin_amdgcn_readfirstlane(tid >> 6);
    unsigned ckof[2], cvof[2];
#pragma unroll
    for (int i = 0; i < 2; ++i) {
        const int kr = 8 * dw + 4 * i + (lane >> 4), sk = (kr & 3) | (((kr >> 3) & 3) << 2); ckof[i] = (unsigned)((kr * 128 + (((lane & 15) ^ sk) << 3)) * 2);
        const int vr = 16 * dw + 8 * i + (lane >> 3), f = (vr >> 1) & 7; cvof[i] = (unsigned)((vr * 256 + (((lane & 7) ^ f) << 3)) * 2);
    }
    {
        const char* Kc = (const char*)((const bf16*)(ws + WS_KCMP) + (size_t)bh * 256 * 128);
#pragma unroll
        for (int kt = 0; kt < 4; ++kt) if (kt <= kt_max) {
#pragma unroll
            for (int i = 0; i < 2; ++i) __builtin_amdgcn_global_load_lds((const unsigned*)(Kc + (size_t)kt * 64 * 128 * 2 + ckof[i]), (LAS unsigned*)(lds + kt * 16384 + 8 * dw * 256 + i * 1024), 16, 0, 0); }
    }
    {
        const int gg = tid >> 7, d = tid & 127;
        int bk = d;
        if (d >= 16) { bk = 16 + (d >= 19) + (d >= 21) + (d >= 24) + (d >= 27) + (d >= 31) + (d >= 35) + (d >= 40) + (d >= 46) + (d >= 52) + (d >= 59) + (d >= 67) + (d >= 77) + (d >= 87) + (d >= 99) + (d >= 113); }
        ((LAS float*)(lds + AT_OFF_LUT))[tid] = p.in[I_RB][bk * 8 + h * 4 + gg] * 1.4426950408889634f;
    }
    bf16x8 Qf[4];
    {
        const bf16* qp = (const bf16*)(ws + WS_Q) + mrow * D_ATTN + hq * 128 + 8 * q;
#pragma unroll
        for (int ks = 0; ks < 4; ++ks) Qf[ks] = *(const bf16x8*)(qp + 32 * ks);
    }
    const float* gl = (const float*)(ws + WS_GL) + mrow * 32 + hq * 3;
    const float gate_c = 1.f / (1.f + __expf(-gl[0])), gate_s = 1.f / (1.f + __expf(-gl[1])), gate_w = 1.f / (1.f + __expf(-gl[2]));
    f32x4 Otot[8];
    {
        const char* Vc = (const char*)((const bf16*)(ws + WS_VCMPT) + (size_t)bh * 128 * 256);
        const LAS float* lut = (const LAS float*)(lds + AT_OFF_LUT) + g * 128;
        f32x4 SA[4][4];
        asm volatile("s_waitcnt vmcnt(0)" ::: "memory");
        __syncthreads();
#pragma unroll
        for (int kt = 0; kt < 4; ++kt) {
            if (kt <= kt_max) at_qk(lds + kt * 16384, Qf, SA[kt], r, q);
            else {
#pragma unroll
                for (int mt = 0; mt < 4; ++mt) SA[kt][mt] = (f32x4){-INFINITY, -INFINITY, -INFINITY, -INFINITY};
            }
        }
        __syncthreads();
#pragma unroll
        for (int kt = 0; kt < 4; ++kt) if (kt <= kt_max) {
#pragma unroll
            for (int i = 0; i < 2; ++i) __builtin_amdgcn_global_load_lds((const unsigned*)(Vc + (size_t)kt * 64 * 2 + cvof[i]), (LAS unsigned*)(lds + kt * 16384 + 16 * dw * 128 + i * 1024), 16, 0, 0); }
        float mx = -INFINITY;
#pragma unroll
        for (int kt = 0; kt < 4; ++kt) if (kt <= kt_max) {
            if ((T0 + 4 * dw) - 16 * (64 * kt + 63) - 31 >= 127) {
                const float b127 = lut[127];
#pragma unroll
                for (int mt = 0; mt < 4; ++mt)
#pragma unroll
                    for (int jj = 0; jj < 4; ++jj) { const float s = SA[kt][mt][jj] + b127; SA[kt][mt][jj] = s; mx = fmaxf(mx, s); }
            } else {
#pragma unroll
                for (int mt = 0; mt < 4; ++mt)
#pragma unroll
                    for (int jj = 0; jj < 4; ++jj) {
                        const int n = 64 * kt + 32 * (mt >> 1) + 8 * q + 4 * (mt & 1) + jj, dist = t - 16 * n - 31;
                        const int di = dist < 0 ? 0 : (dist > 127 ? 127 : dist);
                        const float bv = ((const volatile LAS float*)lut)[di];
                        const float s = (dist >= 0) ? SA[kt][mt][jj] + bv : -INFINITY;
                        SA[kt][mt][jj] = s; mx = fmaxf(mx, s);
                    }
            }
        }
        mx = quad_max(mx);
        const float ms = (mx == -INFINITY) ? 0.f : mx;
        float ps = 0.f;
#pragma unroll
        for (int kt = 0; kt < 4; ++kt) if (kt <= kt_max)
#pragma unroll
            for (int mt = 0; mt < 4; ++mt)
#pragma unroll
                for (int jj = 0; jj < 4; ++jj) { const float e = __builtin_amdgcn_exp2f(SA[kt][mt][jj] - ms); SA[kt][mt][jj] = e; ps += e; }
        ps = quad_sum(ps);
        const float inv = ps > 0.f ? 1.f / ps : 1.f;
        LAS float* impw = (LAS float*)(lds + AT_OFF_IMP) + (g * 32 + tok) * 64 + 2 * q;
        float prevB = 0.f;
#pragma unroll
        for (int kt = 0; kt < 4; ++kt) if (kt <= kt_max)
#pragma unroll
            for (int pr = 0; pr < 2; ++pr) {
                SA[kt][2 * pr] = SA[kt][2 * pr] * inv; SA[kt][2 * pr + 1] = SA[kt][2 * pr + 1] * inv;
                const f32x4 pe = SA[kt][2 * pr], po = SA[kt][2 * pr + 1];
                const float Ae = (pe[0] + pe[1]) + (pe[2] + 0.5f * pe[3]), Be = 0.5f * pe[3];
                const float Ao = (po[0] + po[1]) + (po[2] + 0.5f * po[3]), Bo = 0.5f * po[3];
                const float snd = (q == 3) ? prevB : Bo;
                const float rcv = __shfl(snd, (lane - 16) & 63);
                impw[16 * kt + 8 * pr] = Ae + rcv;
                impw[16 * kt + 8 * pr + 1] = Ao + Be;
                prevB = Bo;
            }
        f32x4 O[8];
#pragma unroll
        for (int dt = 0; dt < 8; ++dt) O[dt] = (f32x4){0.f, 0.f, 0.f, 0.f};
        asm volatile("s_waitcnt vmcnt(0)" ::: "memory");
        __syncthreads();
#pragma unroll
        for (int kt = 0; kt < 4; ++kt) if (kt <= kt_max) at_pv(lds + kt * 16384, SA[kt], O, r, q);
        __syncthreads();
#pragma unroll
        for (int dt = 0; dt < 8; ++dt) Otot[dt] = O[dt] * gate_c;
    }
    {
        const LAS float* imp = (const LAS float*)(lds + AT_OFF_IMP);
        LAS float* sc = (LAS float*)(lds + AT_OFF_SC);
#pragma unroll
        for (int k = 0; k < 4; ++k) {
            const int cell = tid + 512 * k, tk = cell >> 6, jb = cell & 63;
            float v;
            if (jb == 0 || jb == jt || jb == jt - 1) v = 5.0f;
            else if (jb <= jt) v = ((imp[(0 * 32 + tk) * 64 + jb] + imp[(1 * 32 + tk) * 64 + jb]) + imp[(2 * 32 + tk) * 64 + jb]) + imp[(3 * 32 + tk) * 64 + jb];
            else v = -1.0f;
            sc[cell] = v;
        }
        __syncthreads();
        LAS u64* masks = (LAS u64*)(lds + AT_OFF_MASK);
#pragma unroll
        for (int k = 0; k < 4; ++k) {
            const int tk = wave * 4 + k;
            const float mine = sc[tk * 64 + lane];
            int cnt = 0;
            for (int c = 0; c <= (jt >> 4); ++c)
#pragma unroll
                for (int jj = 0; jj < 16; ++jj) { const int jb = 16 * c + jj; const float o = sc[tk * 64 + jb]; cnt += (o > mine || (o == mine && jb < lane)) ? 1 : 0; }
            const u64 mk = __ballot(cnt < 16);
            if (lane == 0) masks[tk] = mk;
        }
        __syncthreads();
    }
    u64 mymask, active, wavemask;
    LAS f32x4* const park = (LAS f32x4*)(lds + AT_OFF_PARK) + wave * 512 + lane;
#pragma unroll
    for (int dt = 0; dt < 8; ++dt) park[64 * dt] = Otot[dt];
    {
        const LAS u64* masks = (const LAS u64*)(lds + AT_OFF_MASK);
        mymask = masks[tok];
        wavemask = (masks[4 * wave] | masks[4 * wave + 1]) | (masks[4 * wave + 2] | masks[4 * wave + 3]);
        u64 a = masks[lane & 31];
#pragma unroll
        for (int o = 1; o < 32; o <<= 1) { const unsigned lo = __shfl_xor((unsigned)a, o), hi = __shfl_xor((unsigned)(a >> 32), o); a |= ((u64)hi << 32) | lo; }
        active = a;
    }
    {
        f32x4 O[8];
#pragma unroll
        for (int dt = 0; dt < 8; ++dt) O[dt] = (f32x4){0.f, 0.f, 0.f, 0.f};
        float m = 0.f, l = 0.f;
        attn_branch<0>(lds, (const bf16*)(ws + WS_KS) + (size_t)bh * SEQ * 128, (const bf16*)(ws + WS_VST) + (size_t)bh * 128 * SEQ, 0, jt, active, mymask, wavemask, t, g, Qf, O, m, l, tid, r, q);
        l = quad_sum(l);
        const float sc = l > 0.f ? gate_s / l : 0.f;
#pragma unroll
        for (int dt = 0; dt < 8; ++dt) park[64 * dt] = park[64 * dt] + O[dt] * sc;
    }
    {
        f32x4 O[8];
#pragma unroll
        for (int dt = 0; dt < 8; ++dt) O[dt] = (f32x4){0.f, 0.f, 0.f, 0.f};
        float m = 0.f, l = 0.f;
        const int lo_pos = T0 - 511; const int j_lo = lo_pos <= 0 ? 0 : (lo_pos >> 6);
        attn_branch<1>(lds, (const bf16*)(ws + WS_KW) + (size_t)bh * SEQ * 128, (const bf16*)(ws + WS_VWT) + (size_t)bh * 128 * SEQ, j_lo, jt, ~0ull, ~0ull, ~0ull, t, g, Qf, O, m, l, tid, r, q);
        l = quad_sum(l);
        const float sc = l > 0.f ? gate_w / l : 0.f;
#pragma unroll
        for (int dt = 0; dt < 8; ++dt) Otot[dt] = park[64 * dt] + O[dt] * sc;
    }
    {
        float ss = 0.f;
#pragma unroll
        for (int dt = 0; dt < 8; ++dt) ss += (Otot[dt][0] * Otot[dt][0] + Otot[dt][1] * Otot[dt][1]) + (Otot[dt][2] * Otot[dt][2] + Otot[dt][3] * Otot[dt][3]);
        ss = quad_sum(ss);
        const float rn = 1.0f / sqrtf(ss * (1.f / 128.f) + EPS);
        const float* gw = p.in[I_AGNW] + hq * 128 + 4 * q;
        bf16* mx = (bf16*)(ws + WS_MIXED) + mrow * D_MODEL + hq * 128 + 4 * q;
#pragma unroll
        for (int dt = 0; dt < 8; ++dt) { const f32x4 w = *(const f32x4*)(gw + 16 * dt);
            u32x2 o; o.x = pk2(Otot[dt][0] * rn * w[0], Otot[dt][1] * rn * w[1]); o.y = pk2(Otot[dt][2] * rn * w[2], Otot[dt][3] * rn * w[3]);
            *(u32x2*)(mx + 16 * dt) = o; }
    }
}
__device__ __forceinline__ unsigned ord_key(float v) { const unsigned u = __builtin_bit_cast(unsigned, v); return (u & 0x80000000u) ? ~u : (u | 0x80000000u); }
__device__ __forceinline__ float ord_val(unsigned k) { const unsigned u = (k & 0x80000000u) ? (k & 0x7fffffffu) : ~k; return __builtin_bit_cast(float, u); }
#define PK_INSERT16(key) do { unsigned _k = (key); _Pragma("unroll") for (int _i = 0; _i < 16; ++_i) { const unsigned _hi = top[_i] > _k ? top[_i] : _k; _k = top[_i] > _k ? _k : top[_i]; top[_i] = _hi; } } while (0)
#define PK_CE(a, b) do { const unsigned _x = (a) > (b) ? (a) : (b); const unsigned _y = (a) > (b) ? (b) : (a); (a) = _x; (b) = _y; } while (0)
template <int XM> __device__ __forceinline__ unsigned pk_xor_lane(unsigned v, bool hi) {
    if (XM == 1) return (unsigned)__builtin_amdgcn_update_dpp(0, (int)v, 0xB1, 0xf, 0xf, false);
    if (XM == 2) return (unsigned)__builtin_amdgcn_update_dpp(0, (int)v, 0x4E, 0xf, 0xf, false);
    if (XM == 16) { const auto s = __builtin_amdgcn_permlane16_swap(v, v, false, false); const unsigned s0 = s[0], s1 = s[1]; return hi ? s0 : s1; }
    { const auto s = __builtin_amdgcn_permlane32_swap(v, v, false, false); const unsigned s0 = s[0], s1 = s[1]; return hi ? s0 : s1; }
}
#define PK_MERGE(xm) do { unsigned _o[16]; const bool _hi = (lane & (xm)) != 0; _Pragma("unroll") for (int _i = 0; _i < 16; ++_i) _o[_i] = pk_xor_lane<xm>(top[15 - _i], _hi); \
    _Pragma("unroll") for (int _i = 0; _i < 16; ++_i) top[_i] = top[_i] > _o[_i] ? top[_i] : _o[_i]; \
    _Pragma("unroll") for (int _s = 8; _s >= 1; _s >>= 1) { _Pragma("unroll") for (int _i = 0; _i < 16; ++_i) if ((_i & _s) == 0) PK_CE(top[_i], top[_i + _s]); } } while (0)

#define PK_SORT16(a) do { PK_CE((a)[0], (a)[13]); PK_CE((a)[1], (a)[12]); PK_CE((a)[2], (a)[15]); PK_CE((a)[3], (a)[14]); PK_CE((a)[4], (a)[8]); PK_CE((a)[5], (a)[6]); PK_CE((a)[7], (a)[11]); PK_CE((a)[9], (a)[10]); PK_CE((a)[0], (a)[5]); PK_CE((a)[1], (a)[7]); PK_CE((a)[2], (a)[9]); PK_CE((a)[3], (a)[4]); PK_CE((a)[6], (a)[13]); PK_CE((a)[8], (a)[14]); PK_CE((a)[10], (a)[15]); PK_CE((a)[11], (a)[12]); PK_CE((a)[0], (a)[1]); PK_CE((a)[2], (a)[3]); PK_CE((a)[4], (a)[5]); PK_CE((a)[6], (a)[8]); PK_CE((a)[7], (a)[9]); PK_CE((a)[10], (a)[11]); PK_CE((a)[12], (a)[13]); PK_CE((a)[14], (a)[15]); PK_CE((a)[0], (a)[2]); PK_CE((a)[1], (a)[3]); PK_CE((a)[4], (a)[10]); PK_CE((a)[5], (a)[11]); PK_CE((a)[6], (a)[7]); PK_CE((a)[8], (a)[9]); PK_CE((a)[12], (a)[14]); PK_CE((a)[13], (a)[15]); PK_CE((a)[1], (a)[2]); PK_CE((a)[3], (a)[12]); PK_CE((a)[4], (a)[6]); PK_CE((a)[5], (a)[7]); PK_CE((a)[8], (a)[10]); PK_CE((a)[9], (a)[11]); PK_CE((a)[13], (a)[14]); PK_CE((a)[1], (a)[4]); PK_CE((a)[2], (a)[6]); PK_CE((a)[5], (a)[8]); PK_CE((a)[7], (a)[10]); PK_CE((a)[9], (a)[13]); PK_CE((a)[11], (a)[14]); PK_CE((a)[2], (a)[4]); PK_CE((a)[3], (a)[6]); PK_CE((a)[9], (a)[12]); PK_CE((a)[11], (a)[13]); PK_CE((a)[3], (a)[5]); PK_CE((a)[6], (a)[8]); PK_CE((a)[7], (a)[9]); PK_CE((a)[10], (a)[12]); PK_CE((a)[3], (a)[4]); PK_CE((a)[5], (a)[6]); PK_CE((a)[7], (a)[8]); PK_CE((a)[9], (a)[10]); PK_CE((a)[11], (a)[12]); PK_CE((a)[6], (a)[7]); PK_CE((a)[8], (a)[9]); } while (0)
#define PK_TOP16_OF_32(a) do { PK_SORT16(a); PK_SORT16((a) + 16); \
    _Pragma("unroll") for (int _i = 0; _i < 16; ++_i) (a)[_i] = (a)[_i] > (a)[31 - _i] ? (a)[_i] : (a)[31 - _i]; \
    _Pragma("unroll") for (int _s = 8; _s >= 1; _s >>= 1) { _Pragma("unroll") for (int _i = 0; _i < 16; ++_i) if ((_i & _s) == 0) PK_CE((a)[_i], (a)[_i + _s]); } } while (0)
__device__ __forceinline__ void peer_topk_pass(const Params& p, LAS unsigned char* lds, int pass, int tid, int lane, int wave) {
    unsigned char* ws = p.ws;
    const int t0 = pass * 32, r = lane & 15, q = lane >> 4;
    LAS unsigned* lists = (LAS unsigned*)lds;
    const bf16* PQ = (const bf16*)(ws + WS_PQ);
    const bf16* SK = (const bf16*)(ws + WS_SK);
#pragma unroll 1
    for (int k = 0; k < 2; ++k) {
        const int hc = wave * 2 + k;
        bf16x8 bq0[4], bq1[4];
        const bf16* qp = PQ + (size_t)(t0 + r) * D_MODEL + hc * 128 + 8 * q;
#pragma unroll
        for (int ks = 0; ks < 4; ++ks) { bq0[ks] = *(const bf16x8*)(qp + 32 * ks); bq1[ks] = *(const bf16x8*)(qp + (size_t)16 * D_MODEL + 32 * ks); }
        const bf16* ap = SK + (size_t)hc * 128 * 128 + (size_t)r * 128 + 8 * q;
        unsigned ka[32], kb[32];
        bf16x8 ac[4], an[4];
#pragma unroll
        for (int ks = 0; ks < 4; ++ks) ac[ks] = *(const bf16x8*)(ap + 32 * ks);
#pragma unroll
        for (int mt = 0; mt < 8; ++mt) {
            if (mt < 7) {
#pragma unroll
                for (int ks = 0; ks < 4; ++ks) an[ks] = *(const bf16x8*)(ap + (size_t)(mt + 1) * 16 * 128 + 32 * ks);
            }
            f32x4 s0 = {0.f, 0.f, 0.f, 0.f}, s1 = {0.f, 0.f, 0.f, 0.f};
#pragma unroll
            for (int ks = 0; ks < 4; ++ks) { s0 = __builtin_amdgcn_mfma_f32_16x16x32_bf16(ac[ks], bq0[ks], s0, 0, 0, 0); s1 = __builtin_amdgcn_mfma_f32_16x16x32_bf16(ac[ks], bq1[ks], s1, 0, 0, 0); }
#pragma unroll
            for (int j = 0; j < 4; ++j) { const unsigned nidx = (unsigned)(127 - (16 * mt + 4 * q + j));
                ka[4 * mt + j] = (ord_key(s0[j]) & ~127u) | nidx; kb[4 * mt + j] = (ord_key(s1[j]) & ~127u) | nidx; }
            if (mt < 7) {
#pragma unroll
                for (int ks = 0; ks < 4; ++ks) ac[ks] = an[ks];
            }
        }
        unsigned top[16];
        PK_TOP16_OF_32(ka);
#pragma unroll
        for (int i = 0; i < 16; ++i) top[i] = ka[i];
        PK_MERGE(16); PK_MERGE(32);
        if (q == 0) { LAS unsigned* o = lists + (r * 16 + hc) * 16;
#pragma unroll
            for (int i = 0; i < 16; ++i) o[i] = top[i]; }
        PK_TOP16_OF_32(kb);
#pragma unroll
        for (int i = 0; i < 16; ++i) top[i] = kb[i];
        PK_MERGE(16); PK_MERGE(32);
        if (q == 0) { LAS unsigned* o = lists + ((16 + r) * 16 + hc) * 16;
#pragma unroll
            for (int i = 0; i < 16; ++i) o[i] = top[i]; }
    }
    __syncthreads();
#pragma unroll 1
    for (int rr = 0; rr < 2; ++rr) {
        const int row = rr * 128 + (tid >> 2), c = tid & 3, tl = row >> 3, hh = row & 7;
        const LAS unsigned* l0 = lists + (tl * 16 + hh * 2) * 16; const LAS unsigned* l1 = l0 + 16;
        unsigned top[16];
#pragma unroll
        for (int i = 0; i < 16; ++i) {
            const int k = c + 4 * i;
            if (i < 13) {
                int ci = (k >= 16) + (k >= 24) + (k >= 29) + (k >= 33) + (k >= 36) + (k >= 38) + (k >= 40) + (k >= 42);
                ci += (k >= 43) ? (k - 42) : 0;
                const int st = ci == 0 ? 0 : ci == 1 ? 16 : ci == 2 ? 24 : ci == 3 ? 29 : ci == 4 ? 33 : ci == 5 ? 36 : ci == 6 ? 38 : ci == 7 ? 40 : (34 + ci);
                const int cj = k - st;
                const bool valid = k < 50;
                const float v = ord_val(l0[valid ? ci : 0] & ~127u) + ord_val(l1[valid ? cj : 0] & ~127u);
                top[i] = valid ? ((ord_key(v) & ~255u) | (unsigned)(255 - (ci * 16 + cj))) : 0u;
            } else top[i] = 0u;
        }
        PK_SORT16(top);
        PK_MERGE(1); PK_MERGE(2);
        if (c == 0) {
            float cv[16]; int ex[16]; float mx = -INFINITY;
#pragma unroll
            for (int i = 0; i < 16; ++i) { const int ci = 255 - (int)(top[i] & 255u), ii = ci >> 4, jj = ci & 15;
                const unsigned ka = l0[ii], kb = l1[jj];
                cv[i] = ord_val(ka & ~127u) + ord_val(kb & ~127u); mx = fmaxf(mx, cv[i]);
                ex[i] = (127 - (int)(ka & 127u)) * 128 + (127 - (int)(kb & 127u)); }
            float sum = 0.f;
#pragma unroll
            for (int i = 0; i < 16; ++i) { cv[i] = __expf(cv[i] - mx); sum += cv[i]; }
            const float inv = 1.f / sum;
            int* eo = (int*)(ws + WS_EIDX) + (size_t)(t0 + tl) * 128 + hh * 16; float* go = (float*)(ws + WS_EW) + (size_t)(t0 + tl) * 128 + hh * 16;
#pragma unroll
            for (int i = 0; i < 16; ++i) { eo[i] = ex[i]; go[i] = cv[i] * inv; }
        }
    }
    __syncthreads();
}

constexpr int NSLICE = 16;
constexpr float U_SCALE = 1024.f, V_SCALE = 256.f;
__device__ __forceinline__ float gelu_tanh(float x) {
    const float u = 0.7978845608028654f * (x + 0.044715f * x * x * x);
    const float e = __expf(2.f * u);
    const float th = 1.f - 2.f / (e + 1.f);
    return 0.5f * x * (1.f + th);
}
struct XcdShare { int xi, nx, wx, nwx; };
__device__ __forceinline__ XcdShare xcd_share(const XcdBarrier& bar, LAS unsigned char* lds, int tid, int wave) {
    volatile LAS unsigned* st = bar.st;
    if (tid == 0) {
        unsigned xi = 0, nx = 0;
#pragma unroll
        for (unsigned j = 0; j < 16; ++j) { const unsigned c = xb_ld(&bar.bar[XB_XCNT(j)]); nx += (c > 0u) ? 1u : 0u; xi += (c > 0u && j < bar.x) ? 1u : 0u; }
        st[3] = xi; st[4] = nx;
    }
    __syncthreads();
#ifdef PROBE_NOAFF
    XcdShare s; s.xi = 0; s.nx = 1; s.wx = blockIdx.x * NWAVES + wave; s.nwx = gridDim.x * NWAVES;
#else
    XcdShare s; s.xi = (int)st[3]; s.nx = (int)st[4]; const int nloc = (int)st[0], rank = (int)st[2];
    s.wx = rank * NWAVES + wave; s.nwx = nloc * NWAVES;
#endif
    return s;
}
struct UnitMap { int xi, nx, wx, nwx, ntok, N, tm; };
__device__ __forceinline__ UnitMap unit_map(const XcdShare& xs) {
    UnitMap m; m.xi = __builtin_amdgcn_readfirstlane(xs.xi); m.nx = __builtin_amdgcn_readfirstlane(xs.nx); m.wx = __builtin_amdgcn_readfirstlane(xs.wx); m.nwx = __builtin_amdgcn_readfirstlane(xs.nwx);
    m.ntok = (xs.wx < T_TOK) ? (T_TOK - 1 - xs.wx) / xs.nwx + 1 : 0;
    const int nsl = (xs.xi < NSLICE) ? (NSLICE - 1 - xs.xi) / xs.nx + 1 : 0;
    m.N = m.ntok * nsl; m.tm = 0; return m;
}
__device__ __forceinline__ void unit_st(const UnitMap& m, int n, int& s, int& t) {
    if (m.tm) { const int ti = n >> 1, si = n & 1; s = m.xi + si * m.nx; t = m.wx + ti * m.nwx; }
    else { const int si = n / m.ntok, ti = n - si * m.ntok; s = m.xi + si * m.nx; t = m.wx + ti * m.nwx; } }
__device__ __forceinline__ u32x4 copy4(const u32x4& s) { u32x4 d; asm volatile("v_mov_b32 %0, %4\n\tv_mov_b32 %1, %5\n\tv_mov_b32 %2, %6\n\tv_mov_b32 %3, %7" : "=&v"(d.x), "=&v"(d.y), "=&v"(d.z), "=&v"(d.w) : "v"(s.x), "v"(s.y), "v"(s.z), "v"(s.w)); return d; }
#define FP8X4_TO_F32(d, f0, f1, f2, f3) do { const f32x2 _lo = __builtin_amdgcn_cvt_pk_f32_fp8((int)(d), false), _hi = __builtin_amdgcn_cvt_pk_f32_fp8((int)(d), true); f0 = _lo[0]; f1 = _lo[1]; f2 = _hi[0]; f3 = _hi[1]; } while (0)

struct PIdx { u32x4 e[4]; };
__device__ __forceinline__ void p_load_idx(const Params& p, const UnitMap& m, int n, int sg, PIdx& I) {
    int s, t; unit_st(m, n < m.N ? n : m.N - 1, s, t);
    const u32x4* ep = (const u32x4*)((const int*)(p.ws + WS_EIDX) + (size_t)t * 128 + 16 * sg);
#pragma unroll
    for (int i = 0; i < 4; ++i) I.e[i] = ep[i];
}
__device__ __forceinline__ void gld16(u32x4& d, unsigned voff, const void* sbase) { asm volatile("global_load_dwordx4 %0, %1, %2" : "=v"(d) : "v"(voff), "s"(sbase) : "memory"); }
__device__ __forceinline__ void gld16nt(u32x4& d, unsigned voff, const void* sbase) { asm volatile("global_load_dwordx4 %0, %1, %2 sc0" : "=v"(d) : "v"(voff), "s"(sbase) : "memory"); }
__device__ __forceinline__ void gld8(u32x2& d, unsigned voff, const void* sbase) { asm volatile("global_load_dwordx2 %0, %1, %2" : "=v"(d) : "v"(voff), "s"(sbase) : "memory"); }
template <int N> __device__ __forceinline__ void vm_wait(u32x4& d) { asm volatile("s_waitcnt vmcnt(%1)" : "+v"(d) : "n"(N) : "memory"); }
template <int N> __device__ __forceinline__ void vm_wait2(u32x2& d) { asm volatile("s_waitcnt vmcnt(%1)" : "+v"(d) : "n"(N) : "memory"); }

__device__ __forceinline__ float u2f(unsigned u) { return __builtin_bit_cast(float, u); }
template <int CTRL> __device__ __forceinline__ int dpp_i(int v) { return __builtin_amdgcn_update_dpp(0, v, CTRL, 0xf, 0xf, false); }
template <int CTRL> __device__ __forceinline__ float dpp_f(float v) { return __builtin_bit_cast(float, __builtin_amdgcn_update_dpp(0, __builtin_bit_cast(int, v), CTRL, 0xf, 0xf, false)); }
__device__ __forceinline__ void peer_u_phase(const Params& p, const XcdShare& xs, int lane) {
    const UnitMap m = unit_map(xs); if (m.N == 0) return;
    const int sg = lane >> 3, pp = lane & 7;
    const bool b0 = (lane & 1) != 0, b1 = (lane & 2) != 0, b2 = (lane & 4) != 0;
    const int pos = 16 * sg + (b2 ? 8 : 0) + (b0 ? 4 : 0) + (b1 ? 2 : 0);
    const unsigned poff = 16u * (unsigned)pp, ioff = 64u * (unsigned)sg, xoff = 32u * (unsigned)pp;
    u32x4 seg[16], x0, x1, nx0, nx1, In[4]; unsigned off[16];
    {
        PIdx I0, I1; p_load_idx(p, m, 0, sg, I0); p_load_idx(p, m, 1, sg, I1);
        int s, t; unit_st(m, 0, s, t);
        const u32x4* xp = (const u32x4*)((const bf16*)(p.ws + WS_XN) + (size_t)t * D_MODEL + 128 * s + 16 * pp); x0 = xp[0]; x1 = xp[1];
        const unsigned char* U = p.ws + WS_U + (size_t)s * N_EXPERTS * 128;
        unsigned o0[16];
#pragma unroll
        for (int i = 0; i < 16; ++i) { o0[i] = I0.e[i >> 2][i & 3] * 128u + poff; off[i] = I1.e[i >> 2][i & 3] * 128u + poff; }
        asm volatile("s_waitcnt vmcnt(0)" ::: "memory");
#pragma unroll
        for (int i = 0; i < 16; ++i) gld16nt(seg[i], o0[i], U);
    }
#pragma unroll 1
    for (int n = 0; n < m.N; ++n) {
        int s, t; unit_st(m, n, s, t);
        int s1, t1; unit_st(m, n + 1 < m.N ? n + 1 : m.N - 1, s1, t1);
        int s2, t2; unit_st(m, n + 2 < m.N ? n + 2 : m.N - 1, s2, t2);
        const unsigned char* U1 = p.ws + WS_U + (size_t)s1 * N_EXPERTS * 128;
        const unsigned char* xb = p.ws + WS_XN + ((size_t)t1 * D_MODEL + 128 * s1) * 2;
        const unsigned char* ib = p.ws + WS_EIDX + (size_t)t2 * 512;
        gld16(nx0, xoff, xb); gld16(nx1, xoff + 16u, xb);
        gld16(In[0], ioff, ib); gld16(In[1], ioff + 16u, ib); gld16(In[2], ioff + 32u, ib); gld16(In[3], ioff + 48u, ib);
        float xf[16];
#pragma unroll
        for (int j = 0; j < 4; ++j) { xf[2 * j] = bf_lo(x0[j]); xf[2 * j + 1] = bf_hi(x0[j]); xf[8 + 2 * j] = bf_lo(x1[j]); xf[8 + 2 * j + 1] = bf_hi(x1[j]); }
        float xm = 0.f;
#pragma unroll
        for (int j = 0; j < 16; j += 2) xm = fmaxf(fmaxf(fabsf(xf[j]), fabsf(xf[j + 1])), xm);
        xm = fmaxf(xm, dpp_f<0x141>(xm)); xm = fmaxf(xm, dpp_f<0xB1>(xm)); xm = fmaxf(xm, dpp_f<0x4E>(xm));
        const float xs = xm > 1e-30f ? (127.f / 32767.f) * __builtin_amdgcn_rcpf(xm) : 0.f, sx = xm * (1.f / 127.f);
        unsigned xq[4];
#pragma unroll
        for (int j = 0; j < 4; ++j) { const auto pa = __builtin_amdgcn_cvt_pknorm_i16(xf[4 * j] * xs, xf[4 * j + 1] * xs), pb = __builtin_amdgcn_cvt_pknorm_i16(xf[4 * j + 2] * xs, xf[4 * j + 3] * xs);
            xq[j] = __builtin_amdgcn_perm(__builtin_bit_cast(unsigned, pb), __builtin_bit_cast(unsigned, pa), 0x06040200u); }
        int a[16];
#pragma unroll
        for (int i = 0; i < 16; ++i) {
            vm_wait<21>(seg[i]);
            int d = 0;
#pragma unroll
            for (int j = 0; j < 4; ++j) d = __builtin_amdgcn_sdot4((int)seg[i][j], (int)xq[j], d, false);
            a[i] = d;
            asm volatile("" : "+v"(a[i]) : "v"(seg[i]) : "memory");
            gld16nt(seg[i], off[i], U1);
        }
        vm_wait<16>(nx0); vm_wait<16>(nx1); vm_wait<16>(In[0]); vm_wait<16>(In[1]); vm_wait<16>(In[2]); vm_wait<16>(In[3]);
        x0 = nx0; x1 = nx1;
#pragma unroll
        for (int i = 0; i < 16; ++i) off[i] = In[i >> 2][i & 3] * 128u + poff;
        int v8[8], v4[4], v2[2];
#pragma unroll
        for (int i = 0; i < 8; ++i) { const int snd = b2 ? a[i] : a[8 + i]; const int kp = b2 ? a[8 + i] : a[i]; v8[i] = kp + dpp_i<0x141>(snd); }
#pragma unroll
        for (int i = 0; i < 4; ++i) { const int snd = b0 ? v8[i] : v8[4 + i]; const int kp = b0 ? v8[4 + i] : v8[i]; v4[i] = kp + dpp_i<0xB1>(snd); }
#pragma unroll
        for (int i = 0; i < 2; ++i) { const int snd = b1 ? v4[i] : v4[2 + i]; const int kp = b1 ? v4[2 + i] : v4[i]; v2[i] = kp + dpp_i<0x4E>(snd); }
        *(unsigned*)((bf16*)(p.ws + WS_APART) + ((size_t)s * T_TOK + t) * 128 + pos) = pk2((float)v2[0] * sx, (float)v2[1] * sx);
    }
    asm volatile("s_waitcnt vmcnt(0)" ::: "memory");
}
__device__ __forceinline__ void peer_u_phase_pair(const Params& p, const XcdShare& xs, int lane) {
    UnitMap m = unit_map(xs); if (m.N == 0) return; m.tm = 1;
    const int sg = lane >> 3, pp = lane & 7;
    const bool b0 = (lane & 1) != 0, b1 = (lane & 2) != 0, b2 = (lane & 4) != 0;
    const int pos = 16 * sg + (b2 ? 8 : 0) + (b0 ? 4 : 0) + (b1 ? 2 : 0);
    const unsigned poff = 16u * (unsigned)pp, ioff = 64u * (unsigned)sg, xoff = 32u * (unsigned)pp;
    u32x4 seg[16], nx[4], In[4]; unsigned off[16];
    unsigned xqA[4], xqB[4]; float sx;
#define PU_QUANT(x) do { float xf_[32]; \
        _Pragma("unroll") for (int h_ = 0; h_ < 4; ++h_) _Pragma("unroll") for (int j_ = 0; j_ < 4; ++j_) { xf_[8 * h_ + 2 * j_] = bf_lo(x[h_][j_]); xf_[8 * h_ + 2 * j_ + 1] = bf_hi(x[h_][j_]); } \
        float xm_ = 0.f; \
        _Pragma("unroll") for (int j_ = 0; j_ < 32; j_ += 2) xm_ = fmaxf(fmaxf(fabsf(xf_[j_]), fabsf(xf_[j_ + 1])), xm_); \
        xm_ = fmaxf(xm_, dpp_f<0x141>(xm_)); xm_ = fmaxf(xm_, dpp_f<0xB1>(xm_)); xm_ = fmaxf(xm_, dpp_f<0x4E>(xm_)); \
        const float xs_ = xm_ > 1e-30f ? (127.f / 32767.f) * __builtin_amdgcn_rcpf(xm_) : 0.f; sx = xm_ * (1.f / 127.f); \
        _Pragma("unroll") for (int j_ = 0; j_ < 8; ++j_) { const auto pa_ = __builtin_amdgcn_cvt_pknorm_i16(xf_[4 * j_] * xs_, xf_[4 * j_ + 1] * xs_), pb_ = __builtin_amdgcn_cvt_pknorm_i16(xf_[4 * j_ + 2] * xs_, xf_[4 * j_ + 3] * xs_); \
            const unsigned q_ = __builtin_amdgcn_perm(__builtin_bit_cast(unsigned, pb_), __builtin_bit_cast(unsigned, pa_), 0x06040200u); if (j_ < 4) xqA[j_] = q_; else xqB[j_ - 4] = q_; } } while (0)
    {
        PIdx I0, I1; p_load_idx(p, m, 0, sg, I0); p_load_idx(p, m, 2, sg, I1);
        int s, t; unit_st(m, 0, s, t);
        const u32x4* xpa = (const u32x4*)((const bf16*)(p.ws + WS_XN) + (size_t)t * D_MODEL + 128 * s + 16 * pp);
        const u32x4* xpb = (const u32x4*)((const bf16*)(p.ws + WS_XN) + (size_t)t * D_MODEL + 128 * (s + m.nx) + 16 * pp);
        nx[0] = xpa[0]; nx[1] = xpa[1]; nx[2] = xpb[0]; nx[3] = xpb[1];
        const unsigned char* U = p.ws + WS_U + (size_t)s * N_EXPERTS * 128;
#pragma unroll
        for (int i = 0; i < 16; ++i) off[i] = I0.e[i >> 2][i & 3] * 128u + poff;
#pragma unroll
        for (int i = 0; i < 4; ++i) In[i] = I1.e[i];
        asm volatile("s_waitcnt vmcnt(0)" ::: "memory");
        PU_QUANT(nx);
#pragma unroll
        for (int i = 0; i < 16; ++i) gld16nt(seg[i], off[i], U);
    }
    int a[16];
#pragma unroll 1
    for (int n0 = 0; n0 < m.N; n0 += 2)
#pragma unroll
    for (int hb = 0; hb < 2; ++hb) {
        const int n = n0 + hb;
        int s, t; unit_st(m, n, s, t);
        int s1, t1; unit_st(m, n + 1 < m.N ? n + 1 : m.N - 1, s1, t1);
        int s2, t2; unit_st(m, n + 3 < m.N ? n + 3 : m.N - 1, s2, t2);
        const unsigned char* U1 = p.ws + WS_U + (size_t)s1 * N_EXPERTS * 128;
        if (hb == 1) {
            const unsigned char* xba = p.ws + WS_XN + ((size_t)t1 * D_MODEL + 128 * s1) * 2; const unsigned char* xbb = xba + 128 * 2 * m.nx;
            const unsigned char* ib = p.ws + WS_EIDX + (size_t)t2 * 512;
            gld16(nx[0], xoff, xba); gld16(nx[1], xoff + 16u, xba); gld16(nx[2], xoff, xbb); gld16(nx[3], xoff + 16u, xbb);
            gld16(In[0], ioff, ib); gld16(In[1], ioff + 16u, ib); gld16(In[2], ioff + 32u, ib); gld16(In[3], ioff + 48u, ib); }
#pragma unroll
        for (int i = 0; i < 16; ++i) {
            if (hb == 0) vm_wait<15>(seg[i]); else vm_wait<23>(seg[i]);
            int d = (hb == 0) ? 0 : a[i];
#pragma unroll
            for (int j = 0; j < 4; ++j) d = __builtin_amdgcn_sdot4((int)seg[i][j], (int)(hb == 0 ? xqA[j] : xqB[j]), d, false);
            a[i] = d;
            asm volatile("" : "+v"(a[i]) : "v"(seg[i]) : "memory");
            gld16nt(seg[i], off[i], U1);
        }
        if (hb == 0) {
#pragma unroll
            for (int i = 0; i < 16; ++i) off[i] = In[i >> 2][i & 3] * 128u + poff;
        } else {
            vm_wait<16>(nx[0]); vm_wait<16>(nx[1]); vm_wait<16>(nx[2]); vm_wait<16>(nx[3]); vm_wait<16>(In[0]); vm_wait<16>(In[1]); vm_wait<16>(In[2]); vm_wait<16>(In[3]);
            int v8[8], v4[4], v2[2];
#pragma unroll
            for (int i = 0; i < 8; ++i) { const int snd = b2 ? a[i] : a[8 + i]; const int kp = b2 ? a[8 + i] : a[i]; v8[i] = kp + dpp_i<0x141>(snd); }
#pragma unroll
            for (int i = 0; i < 4; ++i) { const int snd = b0 ? v8[i] : v8[4 + i]; const int kp = b0 ? v8[4 + i] : v8[i]; v4[i] = kp + dpp_i<0xB1>(snd); }
#pragma unroll
            for (int i = 0; i < 2; ++i) { const int snd = b1 ? v4[i] : v4[2 + i]; const int kp = b1 ? v4[2 + i] : v4[i]; v2[i] = kp + dpp_i<0x4E>(snd); }
            *(unsigned*)((bf16*)(p.ws + WS_APART) + ((size_t)m.xi * T_TOK + t) * 128 + pos) = pk2((float)v2[0] * sx, (float)v2[1] * sx);
            PU_QUANT(nx);
        }
    }
#undef PU_QUANT
    asm volatile("s_waitcnt vmcnt(0)" ::: "memory");
}
struct PrPre { float rs; u32x4 e0, e1; float us[8]; f32x4 g0, g1; };
__device__ __forceinline__ void peer_reduce_pre(const Params& p, size_t i, PrPre& P) {
    unsigned char* ws = p.ws;
    const float* gp = (const float*)(ws + WS_EW); const float* R = (const float*)(ws + WS_R);
    const unsigned* ei = (const unsigned*)(ws + WS_EIDX); const float* usc = (const float*)(ws + WS_USC);
    P.rs = R[i >> 4];
    P.e0 = *(const u32x4*)(ei + 8 * i); P.e1 = *(const u32x4*)(ei + 8 * i + 4);
    P.g0 = *(const f32x4*)(gp + 8 * i); P.g1 = *(const f32x4*)(gp + 8 * i + 4);
#pragma unroll
    for (int k = 0; k < 4; ++k) { P.us[k] = usc[P.e0[k]]; P.us[4 + k] = usc[P.e1[k]]; }
}
__device__ __forceinline__ void peer_reduce_post(const Params& p, int npart, size_t i, const PrPre& P) {
    unsigned char* ws = p.ws;
    const bf16* ap = (const bf16*)(ws + WS_APART); u32x2* wo = (u32x2*)(ws + WS_EW2); float* wsc = (float*)(ws + WS_WSC); const float* vsc = (const float*)(ws + WS_VSC);
    float vs[8];
#pragma unroll
    for (int k = 0; k < 4; ++k) { vs[k] = vsc[P.e0[k]]; vs[4 + k] = vsc[P.e1[k]]; }
    float a[8];
#pragma unroll
    for (int k = 0; k < 8; ++k) a[k] = 0.f;
#pragma unroll 8
    for (int s = 0; s < npart; ++s) { const u32x4 v = *(const u32x4*)(ap + (size_t)s * T_TOK * 128 + 8 * i);
        a[0] += bf_lo(v.x); a[1] += bf_hi(v.x); a[2] += bf_lo(v.y); a[3] += bf_hi(v.y); a[4] += bf_lo(v.z); a[5] += bf_hi(v.z); a[6] += bf_lo(v.w); a[7] += bf_hi(v.w); }
    float o[8]; float mx = 0.f;
#pragma unroll
    for (int k = 0; k < 4; ++k) { o[k] = P.g0[k] * gelu_tanh(a[k] * (P.us[k] * P.rs)) * vs[k]; o[4 + k] = P.g1[k] * gelu_tanh(a[4 + k] * (P.us[4 + k] * P.rs)) * vs[4 + k]; }
#pragma unroll
    for (int k = 0; k < 8; ++k) mx = fmaxf(mx, fabsf(o[k]));
    mx = fmaxf(mx, dpp_f<0xB1>(mx)); mx = fmaxf(mx, dpp_f<0x4E>(mx)); mx = fmaxf(mx, dpp_f<0x141>(mx)); mx = fmaxf(mx, dpp_f<0x140>(mx));
    const float qs = mx > 1e-30f ? (127.f / 32767.f) / mx : 0.f;
    u32x2 q;
    { const auto pa = __builtin_amdgcn_cvt_pknorm_i16(o[0] * qs, o[1] * qs), pb = __builtin_amdgcn_cvt_pknorm_i16(o[2] * qs, o[3] * qs);
      q.x = __builtin_amdgcn_perm(__builtin_bit_cast(unsigned, pb), __builtin_bit_cast(unsigned, pa), 0x06040200u); }
    { const auto pa = __builtin_amdgcn_cvt_pknorm_i16(o[4] * qs, o[5] * qs), pb = __builtin_amdgcn_cvt_pknorm_i16(o[6] * qs, o[7] * qs);
      q.y = __builtin_amdgcn_perm(__builtin_bit_cast(unsigned, pb), __builtin_bit_cast(unsigned, pa), 0x06040200u); }
    wo[i] = q;
    if ((i & 15) == 0) wsc[i >> 4] = mx * (1.f / 127.f);
}
__device__ __forceinline__ void peer_reduce(const Params& p, int npart, size_t gtid, size_t gthreads) {
    for (size_t i = gtid; i < (size_t)T_TOK * 128 / 8; i += gthreads) { PrPre P; peer_reduce_pre(p, i, P); peer_reduce_post(p, npart, i, P); }
}
__device__ __forceinline__ void gld4(unsigned& d, unsigned voff, const void* sbase) { asm volatile("global_load_dword %0, %1, %2" : "=v"(d) : "v"(voff), "s"(sbase) : "memory"); }
template <int N> __device__ __forceinline__ void vm_wait1(unsigned& d) { asm volatile("s_waitcnt vmcnt(%1)" : "+v"(d) : "n"(N) : "memory"); }
template <int N> __device__ __forceinline__ void vm_wait4(u32x4& a, u32x4& b, u32x4& c, u32x4& d) { asm volatile("s_waitcnt vmcnt(%4)" : "+v"(a), "+v"(b), "+v"(c), "+v"(d) : "n"(N) : "memory"); }
__device__ __forceinline__ void peer_v_phase(const Params& p, const XcdShare& xs, int lane) {
    const UnitMap m = unit_map(xs); if (m.N == 0) return;
    const int sg = lane >> 3, pp = lane & 7;
    const bool b3 = (lane & 8) != 0;
    const int col = 16 * pp + ((lane & 32) ? 8 : 0) + ((lane & 16) ? 4 : 0) + (b3 ? 2 : 0);
    const unsigned poff = 16u * (unsigned)pp, ioff = 64u * (unsigned)sg, woff = 16u * (unsigned)sg;
    u32x4 seg[16], w8, nw8, In[4]; unsigned off[16], wsc, nwsc;
    {
        PIdx I0, I1; p_load_idx(p, m, 0, sg, I0); p_load_idx(p, m, 1, sg, I1);
        int s, t; unit_st(m, 0, s, t);
        w8 = *(const u32x4*)(p.ws + WS_EW2 + (size_t)t * 128 + 16 * sg);
        wsc = *(const unsigned*)(p.ws + WS_WSC + (size_t)t * 4);
        const unsigned char* V = p.ws + WS_V + (size_t)s * N_EXPERTS * 128;
        unsigned o0[16];
#pragma unroll
        for (int i = 0; i < 16; ++i) { o0[i] = I0.e[i >> 2][i & 3] * 128u + poff; off[i] = I1.e[i >> 2][i & 3] * 128u + poff; }
        asm volatile("s_waitcnt vmcnt(0)" ::: "memory");
#pragma unroll
        for (int i = 0; i < 16; ++i) gld16nt(seg[i], o0[i], V);
    }
#pragma unroll 1
    for (int n = 0; n < m.N; ++n) {
        int s, t; unit_st(m, n, s, t);
        int s1, t1; unit_st(m, n + 1 < m.N ? n + 1 : m.N - 1, s1, t1);
        int s2, t2; unit_st(m, n + 2 < m.N ? n + 2 : m.N - 1, s2, t2);
        const unsigned char* V1 = p.ws + WS_V + (size_t)s1 * N_EXPERTS * 128;
        const unsigned char* wb = p.ws + WS_EW2 + (size_t)t1 * 128;
        const unsigned char* sb = p.ws + WS_WSC + (size_t)t1 * 4;
        const unsigned char* ib = p.ws + WS_EIDX + (size_t)t2 * 512;
        gld16(nw8, woff, wb); gld4(nwsc, 0u, sb);
        gld16(In[0], ioff, ib); gld16(In[1], ioff + 16u, ib); gld16(In[2], ioff + 32u, ib); gld16(In[3], ioff + 48u, ib);
        int acc[16];
#pragma unroll
        for (int g4 = 0; g4 < 4; ++g4) {
            vm_wait4<18>(seg[4 * g4], seg[4 * g4 + 1], seg[4 * g4 + 2], seg[4 * g4 + 3]);
            const int w4 = (int)w8[g4];
#pragma unroll
            for (int j = 0; j < 4; ++j) {
                const unsigned r0 = seg[4 * g4][j], r1 = seg[4 * g4 + 1][j], r2 = seg[4 * g4 + 2][j], r3 = seg[4 * g4 + 3][j];
                const unsigned t0 = __builtin_amdgcn_perm(r1, r0, 0x05010400u), t1 = __builtin_amdgcn_perm(r1, r0, 0x07030602u);
                const unsigned t2 = __builtin_amdgcn_perm(r3, r2, 0x05010400u), t3 = __builtin_amdgcn_perm(r3, r2, 0x07030602u);
                const unsigned c0 = __builtin_amdgcn_perm(t2, t0, 0x05040100u), c1 = __builtin_amdgcn_perm(t2, t0, 0x07060302u);
                const unsigned c2 = __builtin_amdgcn_perm(t3, t1, 0x05040100u), c3 = __builtin_amdgcn_perm(t3, t1, 0x07060302u);
                acc[4 * j] = __builtin_amdgcn_sdot4((int)c0, w4, g4 ? acc[4 * j] : 0, false); acc[4 * j + 1] = __builtin_amdgcn_sdot4((int)c1, w4, g4 ? acc[4 * j + 1] : 0, false);
                acc[4 * j + 2] = __builtin_amdgcn_sdot4((int)c2, w4, g4 ? acc[4 * j + 2] : 0, false); acc[4 * j + 3] = __builtin_amdgcn_sdot4((int)c3, w4, g4 ? acc[4 * j + 3] : 0, false);
            }
            asm volatile("" : "+v"(acc[0]), "+v"(acc[1]), "+v"(acc[2]), "+v"(acc[3]), "+v"(acc[4]), "+v"(acc[5]), "+v"(acc[6]), "+v"(acc[7]) : "v"(seg[4 * g4]), "v"(seg[4 * g4 + 1]), "v"(seg[4 * g4 + 2]), "v"(seg[4 * g4 + 3]) : "memory");
            asm volatile("" : "+v"(acc[8]), "+v"(acc[9]), "+v"(acc[10]), "+v"(acc[11]), "+v"(acc[12]), "+v"(acc[13]), "+v"(acc[14]), "+v"(acc[15]) : "v"(seg[4 * g4]), "v"(seg[4 * g4 + 1]), "v"(seg[4 * g4 + 2]), "v"(seg[4 * g4 + 3]) : "memory");
#pragma unroll
            for (int i = 0; i < 4; ++i) gld16nt(seg[4 * g4 + i], off[4 * g4 + i], V1);
        }
        int v8[8], v4[4], v2[2];
#pragma unroll
        for (int i = 0; i < 8; ++i) { const auto sw = __builtin_amdgcn_permlane32_swap((unsigned)acc[i], (unsigned)acc[8 + i], false, false); const unsigned s0 = sw[0], s1v = sw[1]; v8[i] = (int)s0 + (int)s1v; }
#pragma unroll
        for (int i = 0; i < 4; ++i) { const auto sw = __builtin_amdgcn_permlane16_swap((unsigned)v8[i], (unsigned)v8[4 + i], false, false); const unsigned s0 = sw[0], s1v = sw[1]; v4[i] = (int)s0 + (int)s1v; }
#pragma unroll
        for (int i = 0; i < 2; ++i) { const int snd = b3 ? v4[i] : v4[2 + i]; const int kp = b3 ? v4[2 + i] : v4[i]; v2[i] = kp + dpp_i<0x128>(snd); }
        const float ws_t = u2f(wsc);
        *(unsigned*)((bf16*)(p.ws + WS_PD) + (size_t)t * D_MODEL + 128 * s + col) = pk2((float)v2[0] * ws_t, (float)v2[1] * ws_t);
        vm_wait<16>(nw8); vm_wait1<16>(nwsc); vm_wait<16>(In[0]); vm_wait<16>(In[1]); vm_wait<16>(In[2]); vm_wait<16>(In[3]);
        w8 = nw8; wsc = nwsc;
#pragma unroll
        for (int i = 0; i < 16; ++i) off[i] = In[i >> 2][i & 3] * 128u + poff;
    }
    asm volatile("s_waitcnt vmcnt(0)" ::: "memory");
}

__device__ __forceinline__ void peer_v_phase_pair(const Params& p, const XcdShare& xs, int lane, const XcdBarrier& bar, unsigned bar_target, bool wait_bar) {
    UnitMap m = unit_map(xs); if (m.N == 0) { if (wait_bar) xcd_barrier_wait(bar, bar_target); return; } m.tm = 1;
    const int sg = lane >> 3, pp = lane & 7;
    const bool b3 = (lane & 8) != 0;
    const int col = 16 * pp + ((lane & 32) ? 8 : 0) + ((lane & 16) ? 4 : 0) + (b3 ? 2 : 0);
    const unsigned poff = 16u * (unsigned)pp, ioff = 64u * (unsigned)sg, woff = 16u * (unsigned)sg;
    u32x4 seg[16], w8, nw8, In[4]; unsigned off[16], wsc, nwsc, hres;
    const unsigned hoff = 2u * (unsigned)col;
    {
        PIdx I0, I1; p_load_idx(p, m, 0, sg, I0); p_load_idx(p, m, 2, sg, I1);
        int s, t; unit_st(m, 0, s, t);
        const unsigned char* V = p.ws + WS_V + (size_t)s * N_EXPERTS * 128;
#pragma unroll
        for (int i = 0; i < 16; ++i) off[i] = I0.e[i >> 2][i & 3] * 128u + poff;
#pragma unroll
        for (int i = 0; i < 4; ++i) In[i] = I1.e[i];
#pragma unroll
        for (int i = 0; i < 16; ++i) seg[i] = *(const u32x4*)(V + off[i]);
        if (wait_bar) xcd_barrier_wait(bar, bar_target);
        w8 = *(const u32x4*)(p.ws + WS_EW2 + (size_t)t * 128 + 16 * sg);
        wsc = *(const unsigned*)(p.ws + WS_WSC + (size_t)t * 4);
        asm volatile("s_waitcnt vmcnt(0)" ::: "memory");
    }
#pragma unroll 1
    for (int n0 = 0; n0 < m.N; n0 += 2)
#pragma unroll
    for (int hb = 0; hb < 2; ++hb) {
        const int n = n0 + hb;
        int s, t; unit_st(m, n, s, t);
        int s1, t1; unit_st(m, n + 1 < m.N ? n + 1 : m.N - 1, s1, t1);
        int s2, t2; unit_st(m, n + 3 < m.N ? n + 3 : m.N - 1, s2, t2);
        const unsigned char* V1 = p.ws + WS_V + (size_t)s1 * N_EXPERTS * 128;
        const unsigned char* wb = p.ws + WS_EW2 + (size_t)t1 * 128;
        const unsigned char* sb = p.ws + WS_WSC + (size_t)t1 * 4;
        const unsigned char* ib = p.ws + WS_EIDX + (size_t)t2 * 512;
        gld4(hres, hoff, p.ws + WS_XN + ((size_t)t * D_MODEL + 128 * s) * 2);
        if (hb == 1) { gld16(nw8, woff, wb); gld4(nwsc, 0u, sb);
            gld16(In[0], ioff, ib); gld16(In[1], ioff + 16u, ib); gld16(In[2], ioff + 32u, ib); gld16(In[3], ioff + 48u, ib); }
        int acc[16];
#pragma unroll
        for (int g4 = 0; g4 < 4; ++g4) {
            if (hb == 0) vm_wait4<13>(seg[4 * g4], seg[4 * g4 + 1], seg[4 * g4 + 2], seg[4 * g4 + 3]); else vm_wait4<19>(seg[4 * g4], seg[4 * g4 + 1], seg[4 * g4 + 2], seg[4 * g4 + 3]);
            const int w4 = (int)w8[g4];
#pragma unroll
            for (int j = 0; j < 4; ++j) {
                const unsigned r0 = seg[4 * g4][j], r1 = seg[4 * g4 + 1][j], r2 = seg[4 * g4 + 2][j], r3 = seg[4 * g4 + 3][j];
                const unsigned t0 = __builtin_amdgcn_perm(r1, r0, 0x05010400u), t1 = __builtin_amdgcn_perm(r1, r0, 0x07030602u);
                const unsigned t2 = __builtin_amdgcn_perm(r3, r2, 0x05010400u), t3 = __builtin_amdgcn_perm(r3, r2, 0x07030602u);
                const unsigned c0 = __builtin_amdgcn_perm(t2, t0, 0x05040100u), c1 = __builtin_amdgcn_perm(t2, t0, 0x07060302u);
                const unsigned c2 = __builtin_amdgcn_perm(t3, t1, 0x05040100u), c3 = __builtin_amdgcn_perm(t3, t1, 0x07060302u);
                acc[4 * j] = __builtin_amdgcn_sdot4((int)c0, w4, g4 ? acc[4 * j] : 0, false); acc[4 * j + 1] = __builtin_amdgcn_sdot4((int)c1, w4, g4 ? acc[4 * j + 1] : 0, false);
                acc[4 * j + 2] = __builtin_amdgcn_sdot4((int)c2, w4, g4 ? acc[4 * j + 2] : 0, false); acc[4 * j + 3] = __builtin_amdgcn_sdot4((int)c3, w4, g4 ? acc[4 * j + 3] : 0, false);
            }
            asm volatile("" : "+v"(acc[0]), "+v"(acc[1]), "+v"(acc[2]), "+v"(acc[3]), "+v"(acc[4]), "+v"(acc[5]), "+v"(acc[6]), "+v"(acc[7]) : "v"(seg[4 * g4]), "v"(seg[4 * g4 + 1]), "v"(seg[4 * g4 + 2]), "v"(seg[4 * g4 + 3]) : "memory");
            asm volatile("" : "+v"(acc[8]), "+v"(acc[9]), "+v"(acc[10]), "+v"(acc[11]), "+v"(acc[12]), "+v"(acc[13]), "+v"(acc[14]), "+v"(acc[15]) : "v"(seg[4 * g4]), "v"(seg[4 * g4 + 1]), "v"(seg[4 * g4 + 2]), "v"(seg[4 * g4 + 3]) : "memory");
#pragma unroll
            for (int i = 0; i < 4; ++i) gld16nt(seg[4 * g4 + i], off[4 * g4 + i], V1);
        }
        int v8[8], v4[4], v2[2];
#pragma unroll
        for (int i = 0; i < 8; ++i) { const auto sw = __builtin_amdgcn_permlane32_swap((unsigned)acc[i], (unsigned)acc[8 + i], false, false); const unsigned s0 = sw[0], s1v = sw[1]; v8[i] = (int)s0 + (int)s1v; }
#pragma unroll
        for (int i = 0; i < 4; ++i) { const auto sw = __builtin_amdgcn_permlane16_swap((unsigned)v8[i], (unsigned)v8[4 + i], false, false); const unsigned s0 = sw[0], s1v = sw[1]; v4[i] = (int)s0 + (int)s1v; }
#pragma unroll
        for (int i = 0; i < 2; ++i) { const int snd = b3 ? v4[i] : v4[2 + i]; const int kp = b3 ? v4[2 + i] : v4[i]; v2[i] = kp + dpp_i<0x128>(snd); }
        const float ws_t = u2f(wsc);
        vm_wait1<16>(hres);
        *(unsigned*)((bf16*)(p.ws + WS_PD) + (size_t)t * D_MODEL + 128 * s + col) = pk2(bf_lo(hres) + (float)v2[0] * ws_t, bf_hi(hres) + (float)v2[1] * ws_t);
        if (hb == 1) { vm_wait<16>(nw8); vm_wait1<16>(nwsc); vm_wait<16>(In[0]); vm_wait<16>(In[1]); vm_wait<16>(In[2]); vm_wait<16>(In[3]);
            w8 = nw8; wsc = nwsc; }
        else {
#pragma unroll
            for (int i = 0; i < 16; ++i) off[i] = In[i >> 2][i & 3] * 128u + poff; }
    }
    asm volatile("s_waitcnt vmcnt(0)" ::: "memory");
}
__global__ void __launch_bounds__(NTHREADS, 2) fwd_megakernel(Params p) {
    extern __shared__ __attribute__((aligned(16))) unsigned char lds_raw[];
    LAS unsigned char* lds = (LAS unsigned char*)lds_raw;
    const int tid = threadIdx.x, lane = tid & 63, wave = __builtin_amdgcn_readfirstlane(tid >> 6);
    unsigned char* ws = p.ws;
    const int G = gridDim.x;
    const int gw = blockIdx.x * NWAVES + wave, NGW = G * NWAVES;
    const int lo = p.ph_lo, hi = p.ph_hi;
#ifndef PROBE_DOUBLE
#define PROBE_DOUBLE -1
#endif
#define IN(k) (lo <= (k) && (k) < hi)
#define REP(k) for (int _rep = 0; _rep < (((k) == PROBE_DOUBLE && (k) != 1 && (k) != 4 && (k) != 6) ? 2 : 1); ++_rep)
#define GREP(k) ((k) == PROBE_DOUBLE ? 2 : 1)
#define SEAM(k) do { if (IN(k) && IN((k) + 1)) xcd_barrier(bar); } while (0)
#define SEAM_FILL(k, k2, f) do { if (IN(k) && IN(k2)) { const unsigned _tg = xcd_barrier_arrive(bar); \
        convert_i8_rows(p.in[I_PU], ws + WS_U, (float*)(ws + WS_USC), gw, NGW, lane, p.in[I_FNW], U_ROWS_P0 + (f) * U_ROWS_FILL, U_ROWS_P0 + ((f) + 1) * U_ROWS_FILL); \
        xcd_barrier_wait(bar, _tg); } } while (0)

    if (tid < 16) ((volatile LAS unsigned*)(lds + LDS_CTL_OFF))[tid] = 0u;
    __syncthreads();
    XcdBarrier bar = xcd_barrier_post((unsigned*)(ws + WS_CTL), (volatile LAS unsigned*)(lds + LDS_CTL_OFF));
#ifdef PROBE_SYNCS
    for (int _i = 0; _i < PROBE_SYNCS; ++_i) xcd_barrier(bar);
#endif
    if (IN(0)) REP(0) { phase_prologue(p, lds, tid, lane, wave); __syncthreads(); }
    SEAM_FILL(0, 1, 0);
    if (IN(1)) REP(1) {
        pg8::Gemm g{(const bf16*)(ws + WS_XN), (const bf16*)(ws + WS_WIN_T), T_TOK, N_IN_PAD, D_MODEL};
        pg8::StaticOrder S; S.init(T_TOK, N_IN_PAD, G, (int)blockIdx.x, GREP(1));
        EpiInProj E{ws, 0.08838834764831845f * 1.4426950408889634f};
        pg8::gemm_phase<EpiInProj, pg8::StaticOrder>(lds, g, S, E);
        if (G >= 256 && (int)blockIdx.x >= 224) { __syncthreads(); square_transposes(p, lds, ((int)blockIdx.x - 224) * NWAVES + wave, (G - 224) * NWAVES, lane, wave); }
    }
    if (IN(1) && IN(2) && G >= 256) {
        const unsigned _tg = xcd_barrier_arrive(bar);
        if (blockIdx.x < 128) {
            const float ccv = compress_cconst(p, blockIdx.x, tid);
            xcd_barrier_wait(bar, _tg);
            compress_unit(p, lds, blockIdx.x, tid, lane, wave, ccv);
        } else {
            convert_i8_rows(p.in[I_PU], ws + WS_U, (float*)(ws + WS_USC), (blockIdx.x - 128) * NWAVES + wave, (G - 128) * NWAVES, lane, p.in[I_FNW], U_ROWS_P0 + 1 * U_ROWS_FILL, U_ROWS_P0 + 2 * U_ROWS_FILL);
            convert_i8_rows(p.in[I_PU], ws + WS_U, (float*)(ws + WS_USC), (blockIdx.x - 128) * NWAVES + wave, (G - 128) * NWAVES, lane, p.in[I_FNW], N_EXPERTS - U_ROWS_P2, N_EXPERTS);
            convert_i8_rows(p.in[I_PV], ws + WS_V, (float*)(ws + WS_VSC), (blockIdx.x - 128) * NWAVES + wave, (G - 128) * NWAVES, lane, nullptr, 0, N_EXPERTS - V_ROWS_LATE);
            xcd_barrier_wait(bar, _tg);
        }
    } else {
        SEAM_FILL(1, 2, 1);
        if (IN(2)) {
            if (G >= 256) {
                if (blockIdx.x < 128) compress_unit(p, lds, blockIdx.x, tid, lane, wave, compress_cconst(p, blockIdx.x, tid));
                else { convert_i8_rows(p.in[I_PU], ws + WS_U, (float*)(ws + WS_USC), (blockIdx.x - 128) * NWAVES + wave, (G - 128) * NWAVES, lane, p.in[I_FNW], N_EXPERTS - U_ROWS_P2, N_EXPERTS);
                       convert_i8_rows(p.in[I_PV], ws + WS_V, (float*)(ws + WS_VSC), (blockIdx.x - 128) * NWAVES + wave, (G - 128) * NWAVES, lane, nullptr, 0, N_EXPERTS - V_ROWS_LATE); }
            } else {
                for (int m = gw; m < T_TOK; m += NGW) conv_token(p, m, lane);
                for (int u = blockIdx.x; u < 128; u += G) compress_unit(p, lds, u, tid, lane, wave, compress_cconst(p, u, tid));
                convert_i8_rows(p.in[I_PU], ws + WS_U, (float*)(ws + WS_USC), gw, NGW, lane, p.in[I_FNW], N_EXPERTS - U_ROWS_P2, N_EXPERTS);
                convert_i8_rows(p.in[I_PV], ws + WS_V, (float*)(ws + WS_VSC), gw, NGW, lane, nullptr, 0, N_EXPERTS - V_ROWS_LATE);
            }
        }
    }
    {
        const bool early = IN(2) && IN(3) && G >= 256;
        if (early) {
            const unsigned _tg = xcd_barrier_arrive(bar);
            convert_i8_rows(p.in[I_PU], ws + WS_U, (float*)(ws + WS_USC), gw, NGW, lane, p.in[I_FNW], U_ROWS_P0 + 2 * U_ROWS_FILL, U_ROWS_P0 + 3 * U_ROWS_FILL);
            conv_tokens(p, gw, NGW, lane);
            xcd_barrier_wait(bar, _tg);
        } else SEAM_FILL(2, 3, 2);
        if (IN(3)) {
            for (int k = 0; ; ++k) {
                const int base = (k >> 1) * 2 * G; if (base >= 512) break;
                const int idx = (k & 1) ? base + 2 * G - 1 - (int)blockIdx.x : base + (int)blockIdx.x;
                if (idx >= 512) continue;
                attn_unit(p, lds, idx, tid, lane, wave);
            }
            if (G >= 256 && !early) conv_tokens(p, gw, NGW, lane);
        }
    }
    SEAM_FILL(3, 4, 3);
    if (IN(4)) REP(4) {
        pg8::Gemm g{(const bf16*)(ws + WS_MIXED), (const bf16*)(ws + WS_WOUT_T), T_TOK, D_MODEL, D_MODEL};
        pg8::StaticOrder S; S.init(T_TOK, D_MODEL, G, (int)blockIdx.x, GREP(4));
        EpiResF32H E{p.in[I_X], (float*)(ws + WS_H), (bf16*)(ws + WS_XN), (float*)(ws + WS_SSP), (const float*)(ws + WS_RX)};
        pg8::gemm_phase<EpiResF32H, pg8::StaticOrder>(lds, g, S, E);
    }
    SEAM_FILL(4, 6, 4);
    if (IN(6)) REP(6) {
        pg8::Gemm g{(const bf16*)(ws + WS_XN), (const bf16*)(ws + WS_WQ_T), T_TOK, D_MODEL, D_MODEL};
        pg8::StaticOrder S; S.init(T_TOK, D_MODEL, G, (int)blockIdx.x, GREP(6));
        EpiBf16Row E{(bf16*)(ws + WS_PQ), D_MODEL, (const float*)(ws + WS_SSP), (float*)(ws + WS_R)};
        pg8::gemm_phase<EpiBf16Row, pg8::StaticOrder>(lds, g, S, E);
    }
    SEAM_FILL(6, 7, 5);
    if (IN(7)) REP(7) {
        for (int u = blockIdx.x; u < T_TOK / 32; u += G) peer_topk_pass(p, lds, u, tid, lane, wave);
    }
    XcdShare xs; xs.xi = 0; xs.nx = 1; xs.wx = 0; xs.nwx = 1;
    if (IN(7) && IN(8)) { const unsigned _tg = xcd_barrier_arrive(bar); xs = xcd_share(bar, lds, tid, wave);
        convert_i8_rows(p.in[I_PV], ws + WS_V, (float*)(ws + WS_VSC), gw, NGW, lane, nullptr, N_EXPERTS - V_ROWS_LATE, N_EXPERTS);
        xcd_barrier_wait(bar, _tg); }
    else { if (IN(8) || IN(9) || IN(10)) xs = xcd_share(bar, lds, tid, wave);
        if (IN(8)) convert_i8_rows(p.in[I_PV], ws + WS_V, (float*)(ws + WS_VSC), gw, NGW, lane, nullptr, N_EXPERTS - V_ROWS_LATE, N_EXPERTS); }
    if (IN(8)) REP(8) {
        if (xs.nx == 8) peer_u_phase_pair(p, xs, lane);
        else peer_u_phase(p, xs, lane);
    }
    {
        const bool one = ((size_t)G * NTHREADS == (size_t)T_TOK * 128 / 8);
        const size_t gi = (size_t)blockIdx.x * NTHREADS + tid;
        PrPre pre;
        if (IN(8) && IN(9)) { const unsigned _tg = xcd_barrier_arrive(bar); if (one) peer_reduce_pre(p, gi, pre); xcd_barrier_wait(bar, _tg); }
        else if (IN(9) && one) peer_reduce_pre(p, gi, pre);
        if (IN(9)) REP(9) {
            const int npart = (xs.nx == 8) ? 8 : 16;
            if (one) peer_reduce_post(p, npart, gi, pre); else peer_reduce(p, npart, gi, (size_t)G * NTHREADS);
        }
    }
    {
        const bool sh = IN(9) && IN(10);
        unsigned tg9 = 0;
        if (sh) tg9 = xcd_barrier_arrive(bar);
        if (IN(10)) {
            if (xs.nx == 8) peer_v_phase_pair(p, xs, lane, bar, tg9, sh);
            else { if (sh) xcd_barrier_wait(bar, tg9); peer_v_phase(p, xs, lane); }
        }
    }
    SEAM(10);
    if (IN(11)) REP(11) {
        final_norm_rows((const bf16*)(ws + WS_XN), (const bf16*)(ws + WS_PD), p.in[I_FINW], p.out, gw, NGW, lane, IN(10) && xs.nx == 8);
    }
#undef IN
#undef SEAM
}

extern "C" void kernel_launch(void* const* d_in, const int* in_sizes, int n_in, void* d_out, int out_size, void* d_ws, size_t ws_size, hipStream_t stream) {
    static int grid_blocks = 0;
    if (grid_blocks == 0) {
        if (n_in != 18 || ws_size < WS_END) { fprintf(stderr, "kernel_launch: unexpected n_in %d / ws_size %zu\n", n_in, ws_size); grid_blocks = -1; return; }
        int dev = 0, cus = 0, per_cu = 0;
        (void)hipGetDevice(&dev);
        (void)hipDeviceGetAttribute(&cus, hipDeviceAttributeMultiprocessorCount, dev);
        (void)hipFuncSetAttribute((const void*)fwd_megakernel, hipFuncAttributeMaxDynamicSharedMemorySize, LDS_BYTES);
        (void)hipOccupancyMaxActiveBlocksPerMultiprocessor(&per_cu, (const void*)fwd_megakernel, NTHREADS, LDS_BYTES);
        if (per_cu < 1) { fprintf(stderr, "kernel_launch: occupancy query says %d blocks/CU\n", per_cu); per_cu = 1; }
        if (per_cu > 1) per_cu = 1;
        grid_blocks = cus * per_cu;
        fprintf(stderr, "kernel_launch: grid %d (cus %d)\n", grid_blocks, cus);
    }
    if (grid_blocks < 0) return;
    (void)hipMemsetAsync((char*)d_ws + WS_CTL, 0, CTL_BYTES, stream);
    Params p{};
    for (int i = 0; i < 18; ++i) p.in[i] = (const float*)d_in[i];
    p.out = (float*)d_out; p.ws = (unsigned char*)d_ws; p.ph_lo = 0; p.ph_hi = 16;
    void* args[] = {&p};
    hipError_t e = hipLaunchCooperativeKernel((const void*)fwd_megakernel, dim3(grid_blocks), dim3(NTHREADS), args, LDS_BYTES, stream);
    if (e != hipSuccess) fprintf(stderr, "cooperative launch failed: %s (grid %d)\n", hipGetErrorString(e), grid_blocks);
}
```
